# Optimizing an MI355X kernel written in HIP

```python
import math
import jax, jax.numpy as jnp
from jax import lax
import numpy as np

D_MODEL = 1024
BATCH = 4
SEQ = 8192
DEPTH = 2

MLA_HEADS = 8
MLA_NOPE_DIM = 128
MLA_ROPE_DIM = 64
MLA_V_DIM = 128
MLA_Q_RANK = 384
MLA_KV_RANK = 256
ROPE_THETA = 10000.0
SWA_Q_HEADS = 16
SWA_KV_HEADS = 4
SWA_HEAD_DIM = 64
WINDOW = 128
REL_BUCKETS = 32
REL_MAX_DIST = 128
D_FF = 4 * D_MODEL
BLOCK = 128
LN_EPS = 1e-5
RMS_EPS = 1e-6

kernel_name = 'yoco_mla_swa_sink_t5_deepnorm'


def _layernorm(x, g, b):
    xf = x.astype(jnp.float32)
    mu = xf.mean(-1, keepdims=True)
    var = jnp.square(xf - mu).mean(-1, keepdims=True)
    return ((xf - mu) * lax.rsqrt(var + LN_EPS) * g + b).astype(x.dtype)


def _rmsnorm(x, g):
    xf = x.astype(jnp.float32)
    return (xf * lax.rsqrt(jnp.mean(xf * xf, -1, keepdims=True) + RMS_EPS) * g).astype(x.dtype)


def _rope(x, pos):
    half = x.shape[-1] // 2
    inv = ROPE_THETA ** (-jnp.arange(half, dtype=jnp.float32) / half)
    ang = pos.astype(jnp.float32)[:, None] * inv[None, :]
    ang = ang.reshape(ang.shape[:1] + (1,) * (x.ndim - 3) + ang.shape[1:])
    cos, sin = jnp.cos(ang), jnp.sin(ang)
    xf = x.astype(jnp.float32)
    x1, x2 = xf[..., :half], xf[..., half:]
    return jnp.concatenate([x1 * cos - x2 * sin, x1 * sin + x2 * cos], -1).astype(x.dtype)


def _t5_bucket(dist):
    n = jnp.maximum(dist, 0)
    max_exact = REL_BUCKETS // 2
    nf = jnp.maximum(n, 1).astype(jnp.float32)
    large = max_exact + (jnp.log(nf / max_exact) / math.log(REL_MAX_DIST / max_exact)
                         * (REL_BUCKETS - max_exact)).astype(jnp.int32)
    large = jnp.minimum(large, REL_BUCKETS - 1)
    return jnp.where(n < max_exact, n, large)


def _to_blocks(t, nb):
    return t.reshape((t.shape[0], nb, BLOCK) + t.shape[2:]).swapaxes(0, 1)


def _mla(x, w_in, g_q, g_kv, w_uq, w_uk, w_uv, w_o, pos):
    B, S, _ = x.shape
    nb = S // BLOCK
    h = x @ w_in
    c_q = _rmsnorm(h[..., :MLA_Q_RANK], g_q)
    c_kv = _rmsnorm(h[..., MLA_Q_RANK:MLA_Q_RANK + MLA_KV_RANK], g_kv)
    k_r = _rope(h[..., MLA_Q_RANK + MLA_KV_RANK:], pos)
    q = jnp.einsum('bsr,rhd->bshd', c_q, w_uq)
    q_n = q[..., :MLA_NOPE_DIM]
    q_r = _rope(q[..., MLA_NOPE_DIM:], pos)
    q_lat = jnp.einsum('bshn,chn->bshc', q_n, w_uk)
    scale = (MLA_NOPE_DIM + MLA_ROPE_DIM) ** -0.5
    kpos = jnp.arange(S)

    def block(args):
        ql, qr, i = args
        s = (jnp.einsum('bqhc,bkc->bhqk', ql, c_kv)
             + jnp.einsum('bqhr,bkr->bhqk', qr, k_r)).astype(jnp.float32) * scale
        qpos = i * BLOCK + jnp.arange(BLOCK)
        s = jnp.where(kpos[None, :] <= qpos[:, None], s, -jnp.inf)
        p = jax.nn.softmax(s, axis=-1).astype(x.dtype)
        return jnp.einsum('bhqk,bkc->bqhc', p, c_kv)

    o_lat = lax.map(block, (_to_blocks(q_lat, nb), _to_blocks(q_r, nb), jnp.arange(nb)))
    o_lat = o_lat.swapaxes(0, 1).reshape(B, S, MLA_HEADS, MLA_KV_RANK)
    o = jnp.einsum('bshc,chv->bshv', o_lat, w_uv).reshape(B, S, MLA_HEADS * MLA_V_DIM)
    return o @ w_o


def _shared_kv(x, w_kv):
    B, S, _ = x.shape
    nb = S // BLOCK
    kv = (x @ w_kv).reshape(B, nb, BLOCK, 2, SWA_KV_HEADS, SWA_HEAD_DIM)
    k, v = kv[:, :, :, 0], kv[:, :, :, 1]

    def band(t):
        prev = jnp.pad(t, ((0, 0), (1, 0), (0, 0), (0, 0), (0, 0)))[:, :-1]
        return jnp.concatenate([prev, t], axis=2)

    return band(k), band(v)


def _swa(x, w_q, sinks, w_o, k_band, v_band, rel_bias):
    B, S, _ = x.shape
    nb = S // BLOCK
    G = SWA_Q_HEADS // SWA_KV_HEADS
    q = (x @ w_q).reshape(B, nb, BLOCK, SWA_KV_HEADS, G, SWA_HEAD_DIM)
    s = jnp.einsum('bnqkgd,bnjkd->bnkgqj', q, k_band).astype(jnp.float32) * SWA_HEAD_DIM ** -0.5
    i = jnp.arange(BLOCK)
    j = jnp.arange(2 * BLOCK)
    dist = i[:, None] + BLOCK - j[None, :]
    bias = rel_bias[_t5_bucket(dist)].astype(jnp.float32)
    bias = bias.transpose(2, 0, 1).reshape(SWA_KV_HEADS, G, BLOCK, 2 * BLOCK)
    kpos = jnp.arange(nb)[:, None] * BLOCK - BLOCK + j[None, :]
    valid = (dist >= 0) & (dist < WINDOW)
    mask = valid[None] & (kpos >= 0)[:, None, :]
    s = jnp.where(mask[None, :, None, None], s + bias, -jnp.inf)
    sink = sinks.astype(jnp.float32).reshape(SWA_KV_HEADS, G)[..., None]
    m = jnp.maximum(s.max(-1), sink)
    p = jnp.exp(s - m[..., None])
    denom = p.sum(-1) + jnp.exp(sink - m)
    p = (p / denom[..., None]).astype(x.dtype)
    o = jnp.einsum('bnkgqj,bnjkd->bnqkgd', p, v_band).reshape(B, S, SWA_Q_HEADS * SWA_HEAD_DIM)
    return o @ w_o


def _mlp(x, w_up, w_down):
    h = jax.nn.relu(x @ w_up)
    return (h * h) @ w_down


def setup_inputs(seed: int = 0) -> dict:
    key = jax.random.key(seed)
    ks = jax.random.split(key, 20)
    n_a = DEPTH // 2
    n_b = DEPTH - n_a
    beta = (8 * DEPTH) ** -0.25
    f32 = jnp.float32

    def nrm(k, shape, fan_in, gain=1.0):
        return jax.random.normal(k, shape, f32) * (gain * fan_in ** -0.5)

    in_w = MLA_Q_RANK + MLA_KV_RANK + MLA_ROPE_DIM
    kv_k = nrm(ks[8], (D_MODEL, 1, SWA_KV_HEADS * SWA_HEAD_DIM), D_MODEL)
    kv_v = nrm(ks[9], (D_MODEL, 1, SWA_KV_HEADS * SWA_HEAD_DIM), D_MODEL, beta)
    return {
        'x': jax.random.normal(ks[0], (BATCH, SEQ, D_MODEL), f32),
        'mla_w_in': nrm(ks[1], (n_a, D_MODEL, in_w), D_MODEL),
        'mla_g_q': 1.0 + 0.05 * jax.random.normal(ks[2], (n_a, MLA_Q_RANK), f32),
        'mla_g_kv': 1.0 + 0.05 * jax.random.normal(ks[3], (n_a, MLA_KV_RANK), f32),
        'mla_w_uq': nrm(ks[4], (n_a, MLA_Q_RANK, MLA_HEADS, MLA_NOPE_DIM + MLA_ROPE_DIM), MLA_Q_RANK),
        'mla_w_uk': nrm(ks[5], (n_a, MLA_KV_RANK, MLA_HEADS, MLA_NOPE_DIM), MLA_KV_RANK),
        'mla_w_uv': nrm(ks[6], (n_a, MLA_KV_RANK, MLA_HEADS, MLA_V_DIM), MLA_KV_RANK, beta),
        'mla_w_o': nrm(ks[7], (n_a, MLA_HEADS * MLA_V_DIM, D_MODEL), MLA_HEADS * MLA_V_DIM, beta),
        'kv_w_shared': jnp.concatenate([kv_k, kv_v], axis=1).reshape(D_MODEL, 2 * SWA_KV_HEADS * SWA_HEAD_DIM),
        'swa_w_q': nrm(ks[10], (n_b, D_MODEL, SWA_Q_HEADS * SWA_HEAD_DIM), D_MODEL),
        'swa_sinks': 0.5 * jax.random.normal(ks[11], (n_b, SWA_Q_HEADS), f32),
        'swa_w_o': nrm(ks[12], (n_b, SWA_Q_HEADS * SWA_HEAD_DIM, D_MODEL), SWA_Q_HEADS * SWA_HEAD_DIM, beta),
        'rel_bias': 0.5 * jax.random.normal(ks[13], (REL_BUCKETS, SWA_Q_HEADS), f32),
        'mlp_w_up': nrm(ks[14], (DEPTH, D_MODEL, D_FF), D_MODEL),
        'mlp_w_down': nrm(ks[15], (DEPTH, D_FF, D_MODEL), D_FF, beta),
        'ln_mix_g': 1.0 + 0.05 * jax.random.normal(ks[16], (DEPTH, D_MODEL), f32),
        'ln_mix_b': 0.02 * jax.random.normal(ks[17], (DEPTH, D_MODEL), f32),
        'ln_mlp_g': 1.0 + 0.05 * jax.random.normal(ks[18], (DEPTH, D_MODEL), f32),
        'ln_mlp_b': 0.02 * jax.random.normal(ks[19], (DEPTH, D_MODEL), f32),
    }


def reference(x, mla_w_in, mla_g_q, mla_g_kv, mla_w_uq, mla_w_uk, mla_w_uv, mla_w_o,
              kv_w_shared, swa_w_q, swa_sinks, swa_w_o, rel_bias,
              mlp_w_up, mlp_w_down, ln_mix_g, ln_mix_b, ln_mlp_g, ln_mlp_b):
    alpha = (2 * DEPTH) ** 0.25
    n_a = DEPTH // 2
    pos = jnp.arange(x.shape[1])
    k_band = v_band = None
    for l in range(DEPTH):
        if l < n_a:
            y = _mla(x, mla_w_in[l], mla_g_q[l], mla_g_kv[l], mla_w_uq[l], mla_w_uk[l],
                     mla_w_uv[l], mla_w_o[l], pos)
        else:
            if l == n_a:
                k_band, v_band = _shared_kv(x, kv_w_shared)
            b = l - n_a
            y = _swa(x, swa_w_q[b], swa_sinks[b], swa_w_o[b], k_band, v_band, rel_bias)
        x = _layernorm(alpha * x + y, ln_mix_g[l], ln_mix_b[l])
        x = _layernorm(alpha * x + _mlp(x, mlp_w_up[l], mlp_w_down[l]), ln_mlp_g[l], ln_mlp_b[l])
    return x
```

```cpp
#include <hip/hip_runtime.h>
#include <cstdio>
#include <cstdint>
#include <hip/hip_cooperative_groups.h>
namespace pg8 {
#define PG8_LAS __attribute__((address_space(3)))
typedef unsigned short bf16_t;
typedef short bf16x8 __attribute__((ext_vector_type(8)));
typedef float f32x4 __attribute__((ext_vector_type(4)));
typedef unsigned u32x4 __attribute__((ext_vector_type(4)));
constexpr int BM = 256, BK = 64, HALF = 128, HTB = HALF * BK * 2  , STAGE_BYTES = 8 * HTB, NXCD = 8, WGM = 8;

__host__ __device__ __forceinline__ int lds_byte(int r, int c) { const int st = (r >> 4) * 2 + (c >> 5), rr = r & 15, cc = c & 31, ob = rr * 64 + cc * 2; return st * 1024 + (ob ^ (((ob >> 9) & 1) << 5)); }
__host__ __device__ __forceinline__ void stage_rc(int b, int& R, int& C) { const int st = b / 1024, sb = b % 1024, swz = sb ^ (((sb >> 9) & 1) << 5); R = (st >> 1) * 16 + swz / 64; C = (st & 1) * 32 + (swz % 64) / 2; }
__host__ __device__ __forceinline__ int perm32(int rho) { const int n = rho >> 4, i = rho & 15; return 8 * (i >> 2) + 4 * n + (i & 3); }

struct Unit { int pm, pn; };
struct Gemm { const bf16_t* A; const bf16_t* Bt; int M, N, K; };

struct StaticOrder {
    int nM, nN, nwg, G, c;
    __host__ __device__ void init(int M, int N, int G_, int c_) { nM = M / BM; nN = N / BM; nwg = nM * nN; G = G_; c = c_; }
    __host__ __device__ bool next(int i, Unit& u) const {
        const long L = (long)i * G + c; if (L >= nwg) return false;
        int wgid = (int)L; { const int q = nwg / NXCD, r = nwg % NXCD, xcd = wgid % NXCD, off = wgid / NXCD; wgid = (xcd < r ? xcd * (q + 1) : r * (q + 1) + (xcd - r) * q) + off; }
        const int nig = WGM * nN, gid = wgid / nig, fm = gid * WGM, gsz = (nM - fm) < WGM ? (nM - fm) : WGM;
        u.pm = fm + ((wgid % nig) % gsz); u.pn = (wgid % nig) / gsz; return true;
    }
    __device__ __forceinline__ void a_ready(const Unit&) const {}
    __device__ __forceinline__ void done(const Unit&) const {}
};

typedef _Float16 f16x8 __attribute__((ext_vector_type(8)));
typedef _Float16 f16x2 __attribute__((ext_vector_type(2)));
__device__ __forceinline__ unsigned cvt_pk_bf16(float lo, float hi) { const f16x2 h = {(_Float16)lo, (_Float16)hi}; return __builtin_bit_cast(unsigned, h); }
typedef float f32x2 __attribute__((ext_vector_type(2)));
__device__ __forceinline__ f32x2 gelu_pk(f32x2 v) {
    const f32x2 av = __builtin_elementwise_abs(v), d = av * 0.2316418882f + 1.0f;
    f32x2 t; t.x = __builtin_amdgcn_rcpf(d.x); t.y = __builtin_amdgcn_rcpf(d.y);
    f32x2 q = t * 0.5307027145f + (-0.7265760135f); q = q * t + 0.7107068705f; q = q * t + (-0.142248368f); q = q * t + 0.127414796f; q = q * t;
    const f32x2 s = (v * v) * (-0.72134752044f);
    f32x2 e; e.x = __builtin_amdgcn_exp2f(s.x); e.y = __builtin_amdgcn_exp2f(s.y);
    const f32x2 m = v * (q * e), r = v - m;
    f32x2 o; o.x = v.x < 0.f ? m.x : r.x; o.y = v.y < 0.f ? m.y : r.y; return o;
}

template <int ACT  > struct EpiBf16 {
    static constexpr bool PERM = true, AFTER_DRAIN = false; static_assert(ACT == 0 || ACT == 1 || ACT == 2, "EpiBf16: ACT is 0 (none), 1 (gelu_pk) or 2 (squared relu)");
    bf16_t* O; int ldc; const float* bias; int split_cols; size_t split_stride; float scale0;
    __device__ __forceinline__ void operator()(const f32x4 (&acc)[2][2][4][2], const Unit& u, int wr, int wc, int fr, int fq) const {
        const int row0 = u.pm * BM + wr * 64 + fr; int colt = u.pn * BM; bf16_t* base = O;
        float sc = 1.f; if (split_cols) { const int t = colt / split_cols; base += (size_t)t * split_stride; colt -= t * split_cols; if (t == 0) sc = scale0; }
        const int col0 = colt + wc * 32 + 8 * fq, bcol0 = u.pn * BM + wc * 32 + 8 * fq;
        f32x4 bv[2][2];
#pragma unroll
        for (int bj = 0; bj < 2; ++bj)
#pragma unroll
            for (int n = 0; n < 2; ++n) bv[bj][n] = bias ? *(const f32x4*)(bias + bcol0 + bj * HALF + 4 * n) : (f32x4){0.f, 0.f, 0.f, 0.f};
#pragma unroll
        for (int ai = 0; ai < 2; ++ai)
#pragma unroll
            for (int m = 0; m < 4; ++m) { bf16_t* rowp = base + (size_t)(row0 + ai * HALF + m * 16) * ldc + col0;
#pragma unroll
                for (int bj = 0; bj < 2; ++bj) { f32x4 v0 = acc[ai][bj][m][0] + bv[bj][0], v1 = acc[ai][bj][m][1] + bv[bj][1];
                    if (ACT == 1) { f32x2 a = gelu_pk((f32x2){v0[0], v0[1]}), b = gelu_pk((f32x2){v0[2], v0[3]}), c = gelu_pk((f32x2){v1[0], v1[1]}), d = gelu_pk((f32x2){v1[2], v1[3]});
                        v0 = (f32x4){a.x, a.y, b.x, b.y}; v1 = (f32x4){c.x, c.y, d.x, d.y}; }
                    if (ACT == 2) { _Pragma("unroll") for (int e = 0; e < 4; ++e) { const float a0 = fmaxf(v0[e], 0.f), a1 = fmaxf(v1[e], 0.f); v0[e] = a0 * a0; v1[e] = a1 * a1; } }
                    v0 = v0 * sc; v1 = v1 * sc; u32x4 w; w.x = cvt_pk_bf16(v0[0], v0[1]); w.y = cvt_pk_bf16(v0[2], v0[3]); w.z = cvt_pk_bf16(v1[0], v1[1]); w.w = cvt_pk_bf16(v1[2], v1[3]);
                    *(u32x4*)(rowp + bj * HALF) = w; } }
    }
};

struct PanelStats {
    unsigned* xbuf;
    unsigned* cnt;
    unsigned* tmo;
    int ntn; float eps;
    unsigned code;
    __device__ __forceinline__ bool run(const f32x4 (&v)[2][2][4][2], const Unit& u, int wr, int wc, int fr, int fq, PG8_LAS unsigned char* lds, int wid, int lane) const {
        typedef float f32x2v __attribute__((ext_vector_type(2)));
        PG8_LAS f32x2v* P = (PG8_LAS f32x2v*)lds;
        PG8_LAS f32x2v* S = (PG8_LAS f32x2v*)(lds + 8192);
        PG8_LAS unsigned* flag = (PG8_LAS unsigned*)(lds + 8192 + 2048);
#pragma unroll
        for (int ai = 0; ai < 2; ++ai)
#pragma unroll
            for (int m = 0; m < 4; ++m) {
                float s = 0.f;
#pragma unroll
                for (int bj = 0; bj < 2; ++bj)
#pragma unroll
                    for (int n = 0; n < 2; ++n) { const f32x4 x = v[ai][bj][m][n]; s += (x[0] + x[1]) + (x[2] + x[3]); }
                s += __shfl_xor(s, 16); s += __shfl_xor(s, 32);
                const float mw = s * (1.0f / 64.0f); float q = 0.f;
#pragma unroll
                for (int bj = 0; bj < 2; ++bj)
#pragma unroll
                    for (int n = 0; n < 2; ++n) { const f32x4 d = v[ai][bj][m][n] - mw; q += (d[0] * d[0] + d[1] * d[1]) + (d[2] * d[2] + d[3] * d[3]); }
                q += __shfl_xor(q, 16); q += __shfl_xor(q, 32);
                if (fq == 0) P[(ai * HALF + wr * 64 + m * 16 + fr) * 4 + wc] = (f32x2v){mw, q};
            }
        asm volatile("s_waitcnt lgkmcnt(0)" ::: "memory"); __builtin_amdgcn_s_barrier(); asm volatile("" ::: "memory");
#if defined(BROKEN_EXCHANGE_NO_WAIT)
#warning BROKEN CONTROL BUILD: the row-statistics exchange does not wait; results are wrong by design
        if (blockIdx.x >= 64) { const long long t0_ = clock64(); while (clock64() - t0_ < 60000) __builtin_amdgcn_s_sleep(8); }
#endif
        const int row = wid * 32 + (lane & 31);
        if (lane < 32) {
            const f32x2v a = P[row * 4 + 0], b = P[row * 4 + 1], c = P[row * 4 + 2], d = P[row * 4 + 3];
            const float mt = (a.x + b.x + c.x + d.x) * 0.25f;
            const float da = a.x - mt, db = b.x - mt, dc = c.x - mt, dd = d.x - mt;
            const float m2 = (a.y + b.y) + (c.y + d.y) + 64.0f * ((da * da + db * db) + (dc * dc + dd * dd));
            unsigned long long* slot = (unsigned long long*)xbuf + ((size_t)(u.pm * BM + row) * 4 + u.pn);
            __hip_atomic_store(slot, ((unsigned long long)__float_as_uint(m2) << 32) | __float_as_uint(mt), __ATOMIC_RELAXED, __HIP_MEMORY_SCOPE_AGENT);
        }
        asm volatile("s_waitcnt vmcnt(0)" ::: "memory");
        if (lane == 0) __hip_atomic_fetch_add(cnt + 64 * u.pm, 1u, __ATOMIC_RELAXED, __HIP_MEMORY_SCOPE_AGENT);
        if (wid == 0) {
            bool dead = false; const unsigned long long t0 = __builtin_amdgcn_s_memrealtime(); const unsigned want = 8u * (unsigned)ntn;
            for (;;) {
#if defined(BROKEN_EXCHANGE_NO_WAIT)
                break;
#endif
                if ((unsigned)__builtin_amdgcn_readfirstlane(__hip_atomic_load(cnt + 64 * u.pm, __ATOMIC_RELAXED, __HIP_MEMORY_SCOPE_AGENT)) >= want) break;
                if (__builtin_amdgcn_s_memrealtime() - t0 > 2000000ull) {
                    if (lane == 0) { unsigned expect = 0u; __hip_atomic_compare_exchange_strong(tmo + 1, &expect, code | (unsigned)(u.pm & 0xff), __ATOMIC_RELAXED, __ATOMIC_RELAXED, __HIP_MEMORY_SCOPE_AGENT);
                                     __hip_atomic_store(tmo, 1u, __ATOMIC_RELAXED, __HIP_MEMORY_SCOPE_AGENT); }
                    dead = true; break; }
                __builtin_amdgcn_s_sleep(2);
            }
            __builtin_amdgcn_fence(__ATOMIC_ACQUIRE, "agent");
            if (lane == 0) flag[0] = dead ? 1u : 0u;
        }
        asm volatile("s_waitcnt vmcnt(0) lgkmcnt(0)" ::: "memory"); __builtin_amdgcn_s_barrier(); asm volatile("" ::: "memory");
        const bool bad = flag[0] != 0u;
        if (lane < 32) {
            const unsigned long long* slot = (const unsigned long long*)xbuf + (size_t)(u.pm * BM + row) * 4; float mt[4], m2[4]; float ms = 0.f;
#pragma unroll
            for (int t = 0; t < 4; ++t) { if (t < ntn) { const unsigned long long w = __hip_atomic_load(slot + t, __ATOMIC_RELAXED, __HIP_MEMORY_SCOPE_AGENT); mt[t] = __uint_as_float((unsigned)w); m2[t] = __uint_as_float((unsigned)(w >> 32)); } else { mt[t] = 0.f; m2[t] = 0.f; } ms += mt[t]; }
            const float mean = ms / (float)ntn; float q = 0.f;
#pragma unroll
            for (int t = 0; t < 4; ++t) if (t < ntn) { const float dm = mt[t] - mean; q += m2[t] + 256.0f * dm * dm; }
            S[row] = (f32x2v){mean, 1.0f / sqrtf(q / (256.0f * (float)ntn) + eps)};
        }
        asm volatile("s_waitcnt lgkmcnt(0)" ::: "memory"); __builtin_amdgcn_s_barrier(); asm volatile("" ::: "memory");
        return bad;
    }
};
struct EpiLnRes {
    static constexpr bool PERM = false, AFTER_DRAIN = true;
    const float* base; float* out; int ldc; const float* bias; PanelStats st; unsigned poison;
    __device__ __forceinline__ void fused(f32x4 (&acc)[2][2][4][2], const Unit& u, int wr, int wc, int fr, int fq, PG8_LAS unsigned char* lds, int wid, int lane) const {
        typedef float f32x2v __attribute__((ext_vector_type(2)));
        const PG8_LAS f32x2v* S = (const PG8_LAS f32x2v*)(lds + 8192);
        const int col0 = u.pn * BM + wc * 32 + 4 * fq;
#pragma unroll
        for (int bj = 0; bj < 2; ++bj)
#pragma unroll
            for (int n = 0; n < 2; ++n) { const f32x4 bv = bias ? *(const f32x4*)(bias + col0 + bj * HALF + n * 16) : (f32x4){0.f, 0.f, 0.f, 0.f};
#pragma unroll
                for (int ai = 0; ai < 2; ++ai)
#pragma unroll
                    for (int m = 0; m < 4; ++m) acc[ai][bj][m][n] += bv; }
        f32x4 pre[4][2][2];
#pragma unroll
        for (int m = 0; m < 4; ++m) { const size_t off = (size_t)(u.pm * BM + wr * 64 + m * 16 + fr) * ldc + col0;
#pragma unroll
            for (int bj = 0; bj < 2; ++bj)
#pragma unroll
                for (int n = 0; n < 2; ++n) pre[m][bj][n] = *(const f32x4*)(base + off + bj * HALF + n * 16); }
        const bool bad = st.run(acc, u, wr, wc, fr, fq, lds, wid, lane) || poison != 0u;
        const float qnan = __builtin_nanf("");
#pragma unroll
        for (int ai = 0; ai < 2; ++ai)
#pragma unroll
            for (int m = 0; m < 4; ++m) { const int r = ai * HALF + wr * 64 + m * 16 + fr; const f32x2v sr = S[r]; const size_t off = (size_t)(u.pm * BM + r) * ldc + col0;
#pragma unroll
                for (int bj = 0; bj < 2; ++bj)
#pragma unroll
                    for (int n = 0; n < 2; ++n) { const f32x4 bs = ai == 0 ? pre[m][bj][n] : *(const f32x4*)(base + off + bj * HALF + n * 16); f32x4 o = bs + (acc[ai][bj][m][n] - sr.x) * sr.y;
                        if (bad) o = (f32x4){qnan, qnan, qnan, qnan}; *(f32x4*)(out + off + bj * HALF + n * 16) = o; }
                if (m & 1) asm volatile("" ::: "memory"); }
    }
};
struct EpiLnResLn {
    static constexpr bool PERM = false, AFTER_DRAIN = true;
    const float* base; float* out; bf16_t* xn; int ldc; const float* bias; PanelStats st1, st2; unsigned poison;
    __device__ __forceinline__ void fused(f32x4 (&acc)[2][2][4][2], const Unit& u, int wr, int wc, int fr, int fq, PG8_LAS unsigned char* lds, int wid, int lane) const {
        typedef float f32x2v __attribute__((ext_vector_type(2))); typedef unsigned u32x2v __attribute__((ext_vector_type(2)));
        const PG8_LAS f32x2v* S = (const PG8_LAS f32x2v*)(lds + 8192);
        const int col0 = u.pn * BM + wc * 32 + 4 * fq;
#pragma unroll
        for (int bj = 0; bj < 2; ++bj)
#pragma unroll
            for (int n = 0; n < 2; ++n) { const f32x4 bv = bias ? *(const f32x4*)(bias + col0 + bj * HALF + n * 16) : (f32x4){0.f, 0.f, 0.f, 0.f};
#pragma unroll
                for (int ai = 0; ai < 2; ++ai)
#pragma unroll
                    for (int m = 0; m < 4; ++m) acc[ai][bj][m][n] += bv; }
        bool bad = st1.run(acc, u, wr, wc, fr, fq, lds, wid, lane) || poison != 0u;
        const float qnan = __builtin_nanf("");
#pragma unroll
        for (int ai = 0; ai < 2; ++ai)
#pragma unroll
            for (int m = 0; m < 4; ++m) { const int r = ai * HALF + wr * 64 + m * 16 + fr; const f32x2v sr = S[r]; const size_t off = (size_t)(u.pm * BM + r) * ldc + col0;
#pragma unroll
                for (int bj = 0; bj < 2; ++bj)
#pragma unroll
                    for (int n = 0; n < 2; ++n) { const f32x4 bs = *(const f32x4*)(base + off + bj * HALF + n * 16); acc[ai][bj][m][n] = bs + (acc[ai][bj][m][n] - sr.x) * sr.y; }
                asm volatile("" : "+v"(acc[ai][0][m][0]), "+v"(acc[ai][0][m][1]), "+v"(acc[ai][1][m][0]), "+v"(acc[ai][1][m][1]));
                if (m & 1) asm volatile("" ::: "memory"); }
        const bool bad1 = bad;
        bad = st2.run(acc, u, wr, wc, fr, fq, lds, wid, lane) || bad;
#pragma unroll
        for (int ai = 0; ai < 2; ++ai)
#pragma unroll
            for (int m = 0; m < 4; ++m) { const int r = ai * HALF + wr * 64 + m * 16 + fr; const f32x2v sr = S[r]; const size_t off = (size_t)(u.pm * BM + r) * ldc + col0;
#pragma unroll
                for (int bj = 0; bj < 2; ++bj)
#pragma unroll
                    for (int n = 0; n < 2; ++n) { const f32x4 x1 = acc[ai][bj][m][n]; *(f32x4*)(out + off + bj * HALF + n * 16) = bad1 ? (f32x4){qnan, qnan, qnan, qnan} : x1;
                        const f32x4 o = (x1 - sr.x) * sr.y; u32x2v w; w.x = cvt_pk_bf16(o[0], o[1]); w.y = cvt_pk_bf16(o[2], o[3]);
                        if (bad) { w.x = 0x7fc07fc0u; w.y = 0x7fc07fc0u; } *(u32x2v*)(xn + off + bj * HALF + n * 16) = w; }
                asm volatile("" ::: "memory"); }
    }
};

template <class Epi, class Sched, bool ALIGN_EPI = false, bool SP2 = false>
__device__ __forceinline__ void gemm_phase(PG8_LAS unsigned char* lds, const Gemm g, const Sched& S, const Epi& E) {
    const int tid = threadIdx.x, wid = __builtin_amdgcn_readfirstlane(tid >> 6), lane = tid & 63, wr = wid >> 2, wc = wid & 3, fr = lane & 15, fq = lane >> 4;
    const int K = g.K, nt = K / BK;
    unsigned voffA[2], voffB[2];
#pragma unroll
    for (int i = 0; i < 2; ++i) { int R, C; stage_rc(tid * 16 + i * 8192, R, C); const int Rb = Epi::PERM ? ((R & ~31) + perm32(R & 31)) : R;
        voffA[i] = (unsigned)(R * K + C) * 2u; voffB[i] = (unsigned)(Rb * K + C) * 2u; }
    const size_t kstep = (size_t)(BK * 2);
    const size_t hstep = (size_t)HALF * K * 2;
    const size_t tstep = 2 * hstep;
    const unsigned ldsw = (unsigned)wid * 1024u;
    const int aoff = lds_byte(wr * 64 + fr, fq * 8), boff = lds_byte(wc * 32 + fr, fq * 8);
#define PG8_SA(b, h) (((b) * 2 + (h)) * HTB)
#define PG8_SB(b, h) ((4 + (b) * 2 + (h)) * HTB)
#define PG8_STAGE(bufoff, gbase, voff) do { _Pragma("unroll") for (int _i = 0; _i < 2; ++_i) \
        __builtin_amdgcn_global_load_lds((const unsigned*)((const char*)(gbase) + (voff)[_i]), (PG8_LAS unsigned*)(lds + (bufoff) + ldsw + _i * 8192), 16, 0, 0); } while (0)
#define PG8_LDA(dst, b, h) do { _Pragma("unroll") for (int m = 0; m < 4; ++m) _Pragma("unroll") for (int k = 0; k < 2; ++k) dst[m][k] = *(const PG8_LAS bf16x8*)(lds + PG8_SA(b, h) + aoff + m * 2048 + k * 1024); } while (0)
#define PG8_LDB(dst, b, h) do { _Pragma("unroll") for (int n = 0; n < 2; ++n) _Pragma("unroll") for (int k = 0; k < 2; ++k) dst[n][k] = *(const PG8_LAS bf16x8*)(lds + PG8_SB(b, h) + boff + n * 2048 + k * 1024); } while (0)
#define PG8_MMA(ai, bj, At, Bt) do { __builtin_amdgcn_s_setprio(1); _Pragma("unroll") for (int m = 0; m < 4; ++m) _Pragma("unroll") for (int n = 0; n < 2; ++n) _Pragma("unroll") for (int k = 0; k < 2; ++k) \
        acc[ai][bj][m][n] = __builtin_amdgcn_mfma_f32_16x16x32_f16(__builtin_bit_cast(f16x8, Bt[n][k]), __builtin_bit_cast(f16x8, At[m][k]), acc[ai][bj][m][n], 0, 0, 0); __builtin_amdgcn_s_setprio(0); } while (0)
#define PG8_WAIT_V(n) asm volatile("s_waitcnt vmcnt(" #n ")" ::: "memory")
#define PG8_WAIT_L(n) asm volatile("s_waitcnt lgkmcnt(" #n ")" ::: "memory")
#define PG8_BAR __builtin_amdgcn_s_barrier()
#define PG8_SCHED __builtin_amdgcn_sched_barrier(0)
    Unit cur, nxt; int ui = 0;
    if (!S.next(0, cur)) return;
    f32x4 acc[2][2][4][2];
#pragma unroll
    for (int a = 0; a < 2; ++a)
#pragma unroll
        for (int b = 0; b < 2; ++b)
#pragma unroll
            for (int m = 0; m < 4; ++m)
#pragma unroll
                for (int n = 0; n < 2; ++n) acc[a][b][m][n] = (f32x4){0.f, 0.f, 0.f, 0.f};
    bf16x8 At[4][2], B0[2][2], B1[2][2];
    const char* cA = (const char*)g.A + (size_t)cur.pm * tstep; const char* cB = (const char*)g.Bt + (size_t)cur.pn * tstep;
    S.a_ready(cur);
    if constexpr (SP2) {
        PG8_STAGE(PG8_SB(0, 0), cB, voffB); PG8_STAGE(PG8_SB(0, 1), cB + hstep, voffB); PG8_STAGE(PG8_SA(0, 0), cA, voffA); PG8_STAGE(PG8_SA(0, 1), cA + hstep, voffA);
        if (wr == 1) PG8_BAR;
        PG8_WAIT_V(2); PG8_BAR;
        PG8_STAGE(PG8_SB(1, 0), cB + kstep, voffB); PG8_STAGE(PG8_SA(1, 0), cA + kstep, voffA); PG8_STAGE(PG8_SB(1, 1), cB + hstep + kstep, voffB);
        PG8_WAIT_V(6); PG8_BAR;
    } else {
        PG8_STAGE(PG8_SB(0, 0), cB, voffB); PG8_STAGE(PG8_SA(0, 0), cA, voffA); PG8_STAGE(PG8_SB(0, 1), cB + hstep, voffB); PG8_STAGE(PG8_SA(0, 1), cA + hstep, voffA);
        if (wr == 1) PG8_BAR;
        PG8_WAIT_V(4); PG8_BAR;
        PG8_STAGE(PG8_SB(1, 0), cB + kstep, voffB); PG8_STAGE(PG8_SA(1, 0), cA + kstep, voffA); PG8_STAGE(PG8_SB(1, 1), cB + hstep + kstep, voffB);
        PG8_WAIT_V(6); PG8_BAR;
    }
    for (;;) {
        const bool has_next = S.next(ui + 1, nxt);
        const char* nA = has_next ? (const char*)g.A + (size_t)nxt.pm * tstep : cA; const char* nB = has_next ? (const char*)g.Bt + (size_t)nxt.pn * tstep : cB;
        for (int t = 0; t < nt; t += 2) {
            const bool last = (t == nt - 2);
            const char* a1 = cA + (size_t)(t + 1) * kstep;
            const char* a2 = last ? nA : cA + (size_t)(t + 2) * kstep; const char* b2 = last ? nB : cB + (size_t)(t + 2) * kstep;
            const char* a3 = a2 + kstep; const char* b3 = b2 + kstep;
            if (last && has_next) S.a_ready(nxt);
            if constexpr (SP2) {
            PG8_LDB(B0, 0, 0); PG8_LDB(B1, 0, 1); PG8_SCHED; PG8_LDA(At, 0, 0); PG8_STAGE(PG8_SA(1, 1), a1 + hstep, voffA);
            PG8_WAIT_V(8); PG8_WAIT_L(0); PG8_BAR; PG8_MMA(0, 0, At, B0); PG8_MMA(0, 1, At, B1); PG8_BAR; PG8_SCHED;
            PG8_LDA(At, 0, 1); PG8_STAGE(PG8_SB(0, 0), b2, voffB); PG8_STAGE(PG8_SB(0, 1), b2 + hstep, voffB); PG8_STAGE(PG8_SA(0, 0), a2, voffA);
            PG8_WAIT_V(8); PG8_WAIT_L(0); PG8_BAR; PG8_MMA(1, 0, At, B0); PG8_MMA(1, 1, At, B1); PG8_BAR; PG8_SCHED;
            PG8_LDB(B0, 1, 0); PG8_LDB(B1, 1, 1); PG8_SCHED; PG8_LDA(At, 1, 0); PG8_STAGE(PG8_SA(0, 1), a2 + hstep, voffA);
            PG8_WAIT_V(8); PG8_WAIT_L(0); PG8_BAR; PG8_MMA(0, 0, At, B0); PG8_MMA(0, 1, At, B1); PG8_BAR; PG8_SCHED;
            PG8_LDA(At, 1, 1); PG8_STAGE(PG8_SB(1, 0), b3, voffB); PG8_STAGE(PG8_SB(1, 1), b3 + hstep, voffB); PG8_STAGE(PG8_SA(1, 0), a3, voffA);
            PG8_WAIT_V(8); PG8_WAIT_L(0); PG8_BAR; PG8_MMA(1, 0, At, B0); PG8_MMA(1, 1, At, B1); PG8_BAR; PG8_SCHED;
            } else {
            PG8_LDB(B0, 0, 0); PG8_SCHED; PG8_LDA(At, 0, 0); PG8_STAGE(PG8_SA(1, 1), a1 + hstep, voffA);
            PG8_WAIT_L(8); PG8_BAR; PG8_WAIT_L(0); PG8_MMA(0, 0, At, B0); PG8_BAR; PG8_SCHED;
            PG8_LDB(B1, 0, 1); PG8_STAGE(PG8_SB(0, 0), b2, voffB);
            PG8_BAR; PG8_WAIT_L(0); PG8_MMA(0, 1, At, B1); PG8_BAR;
            PG8_LDA(At, 0, 1); PG8_STAGE(PG8_SA(0, 0), a2, voffA);
            PG8_BAR; PG8_WAIT_L(0); PG8_MMA(1, 0, At, B0); PG8_BAR; PG8_SCHED;
            PG8_STAGE(PG8_SB(0, 1), b2 + hstep, voffB);
            PG8_WAIT_V(6); PG8_BAR; PG8_MMA(1, 1, At, B1); PG8_BAR;
            PG8_LDB(B0, 1, 0); PG8_SCHED; PG8_LDA(At, 1, 0); PG8_STAGE(PG8_SA(0, 1), a2 + hstep, voffA);
            PG8_WAIT_L(8); PG8_BAR; PG8_WAIT_L(0); PG8_MMA(0, 0, At, B0); PG8_BAR; PG8_SCHED;
            PG8_LDB(B1, 1, 1); PG8_STAGE(PG8_SB(1, 0), b3, voffB);
            PG8_BAR; PG8_WAIT_L(0); PG8_MMA(0, 1, At, B1); PG8_BAR;
            PG8_LDA(At, 1, 1); PG8_STAGE(PG8_SA(1, 0), a3, voffA);
            PG8_BAR; PG8_WAIT_L(0); PG8_MMA(1, 0, At, B0); PG8_BAR; PG8_SCHED;
            PG8_STAGE(PG8_SB(1, 1), b3 + hstep, voffB);
            PG8_WAIT_V(6); PG8_BAR; PG8_MMA(1, 1, At, B1); PG8_BAR;
            }
        }
        if constexpr (ALIGN_EPI) { if (wr == 0) PG8_BAR; }
        if constexpr (!Epi::AFTER_DRAIN) { E(acc, cur, wr, wc, fr, fq); S.done(cur); }
        if (!has_next) break;
#pragma unroll
        for (int a = 0; a < 2; ++a)
#pragma unroll
            for (int b = 0; b < 2; ++b)
#pragma unroll
                for (int m = 0; m < 4; ++m)
#pragma unroll
                    for (int n = 0; n < 2; ++n) acc[a][b][m][n] = (f32x4){0.f, 0.f, 0.f, 0.f};
        cur = nxt; cA = nA; cB = nB; ++ui;
        if constexpr (ALIGN_EPI) { if (wr == 1) PG8_BAR; }
    }
    PG8_WAIT_V(0);
    if constexpr (!ALIGN_EPI) { if (wr == 0) PG8_BAR; }
    PG8_BAR;
    if constexpr (Epi::AFTER_DRAIN) { E.fused(acc, cur, wr, wc, fr, fq, lds, wid, lane); S.done(cur); }
#undef PG8_SA
#undef PG8_SB
#undef PG8_STAGE
#undef PG8_LDA
#undef PG8_LDB
#undef PG8_MMA
#undef PG8_WAIT_V
#undef PG8_WAIT_L
#undef PG8_BAR
#undef PG8_SCHED
}
}

namespace cg = cooperative_groups;
namespace pg8 {
struct EpiF32 {
    static constexpr bool PERM = false, AFTER_DRAIN = false;
    float* O; int ldc; const float* res; float alpha;
    __device__ __forceinline__ void operator()(const f32x4 (&acc)[2][2][4][2], const Unit& u, int wr, int wc, int fr, int fq) const {
        const int row0 = u.pm * BM + wr * 64 + fr, col0 = u.pn * BM + wc * 32 + 4 * fq;
#pragma unroll
        for (int ai = 0; ai < 2; ++ai)
#pragma unroll
            for (int m = 0; m < 4; ++m) { const size_t off = (size_t)(row0 + ai * HALF + m * 16) * ldc + col0;
#pragma unroll
                for (int bj = 0; bj < 2; ++bj)
#pragma unroll
                    for (int n = 0; n < 2; ++n) { f32x4 v = acc[ai][bj][m][n];
                        if (res) { const f32x4 r = *(const f32x4*)(res + off + bj * HALF + n * 16); v = v + r * alpha; }
                        *(f32x4*)(O + off + bj * HALF + n * 16) = v; } }
    }
};
}

constexpr int BATCH = 4, SEQ = 8192, T = BATCH * SEQ, D = 1024, FF = 4096;
constexpr int QRANK = 384, CRANK = 256, RDIM = 64, INW = 704, INWP = 768;
constexpr int H1 = 8, DQK = 192, DV1 = 128, QW1 = H1 * DQK;
constexpr int H2 = 16, KVH2 = 4, HD2 = 64, QKW2 = 1280;
constexpr float LN_EPS = 1e-5f, RMS_EPS = 1e-6f;
constexpr float ALPHA = 1.4142135623730951f;
constexpr float LOG2E = 1.4426950408889634f;
constexpr float QSCALE1 = 0.07216878364870322f * LOG2E;
constexpr float QSCALE2 = 0.125f * LOG2E;

constexpr size_t MiB = 1u << 20;
constexpr size_t WS_CTL = 0, CTL_ZERO_BYTES = 1 * MiB;
constexpr size_t WS_WIN = 2 * MiB;
constexpr size_t WS_WUQ = WS_WIN + (size_t)INWP * D * 2;
constexpr size_t WS_WUK = WS_WUQ + (size_t)QW1 * QRANK * 2;
constexpr size_t WS_WUV = WS_WUK + (size_t)1024 * CRANK * 2;
constexpr size_t WS_WO1 = WS_WUV + (size_t)1024 * CRANK * 2;
constexpr size_t WS_WUP1 = WS_WO1 + (size_t)D * D * 2;
constexpr size_t WS_WDN1 = WS_WUP1 + (size_t)FF * D * 2;
constexpr size_t WS_WQK2 = WS_WDN1 + (size_t)FF * D * 2;
constexpr size_t WS_WV2 = WS_WQK2 + (size_t)QKW2 * D * 2;
constexpr size_t WS_WO2 = WS_WV2 + (size_t)256 * D * 2;
constexpr size_t WS_WUP2 = WS_WO2 + (size_t)D * D * 2;
constexpr size_t WS_WDN2 = WS_WUP2 + (size_t)FF * D * 2;
constexpr size_t WS_WEND = WS_WDN2 + (size_t)FF * D * 2;
static_assert(WS_WEND <= 48 * MiB, "weights region");
constexpr size_t WS_BFA = 48 * MiB;
constexpr size_t WS_F32A = 112 * MiB;
constexpr size_t WS_KN = 112 * MiB, WS_VT = 176 * MiB;
constexpr size_t WS_H = 240 * MiB;
constexpr size_t WS_O = 240 * MiB;
constexpr size_t WS_CQ = 368 * MiB, WS_CKV = 392 * MiB, WS_KR = 408 * MiB, WS_Q = 412 * MiB;
constexpr size_t WS_HB = 240 * MiB;
constexpr size_t WS_QK2 = 240 * MiB, WS_V2T = 320 * MiB, WS_O2 = 336 * MiB;
constexpr size_t WS_END = 508 * MiB;

constexpr int RING_BYTES = 131072;
constexpr int LDS_BYTES = 147456;
constexpr int NWAVES = 8;

#define LAS __attribute__((address_space(3)))
typedef unsigned short bf16;
typedef unsigned v4u __attribute__((ext_vector_type(4)));
typedef unsigned v2u __attribute__((ext_vector_type(2)));
typedef float f32x4 __attribute__((ext_vector_type(4)));
typedef float f32x16 __attribute__((ext_vector_type(16)));
typedef short bf16x8 __attribute__((ext_vector_type(8)));

typedef _Float16 f16x8 __attribute__((ext_vector_type(8)));
typedef _Float16 f16x2 __attribute__((ext_vector_type(2)));
__device__ __forceinline__ unsigned f2bf(float f) { return (unsigned)__builtin_bit_cast(unsigned short, (_Float16)f); }
__device__ __forceinline__ unsigned pk2(float lo, float hi) { const f16x2 h = {(_Float16)lo, (_Float16)hi}; return __builtin_bit_cast(unsigned, h); }
__device__ __forceinline__ float bf2f(unsigned v) { return (float)__builtin_bit_cast(_Float16, (unsigned short)v); }
#define MFMA32(a, b, c) __builtin_amdgcn_mfma_f32_32x32x16_f16(__builtin_bit_cast(f16x8, a), __builtin_bit_cast(f16x8, b), c, 0, 0, 0)
__device__ __forceinline__ int crow(int r, int hi) { return (r & 3) + 8 * (r >> 2) + 4 * hi; }
__device__ __forceinline__ float wave_sum(float v) {
#pragma unroll
    for (int o = 1; o < 64; o <<= 1) v += __shfl_xor(v, o);
    return v;
}
#define LDS_WAIT() asm volatile("s_waitcnt lgkmcnt(0)" ::: "memory")

static __device__ const float ROPE_INV[32] = {
    1.000000000e+00f, 7.498942614e-01f, 5.623413324e-01f, 4.216965139e-01f, 3.162277639e-01f, 2.371373773e-01f, 1.778279394e-01f, 1.333521307e-01f,
    1.000000015e-01f, 7.498941571e-02f, 5.623413250e-02f, 4.216965288e-02f, 3.162277490e-02f, 2.371373773e-02f, 1.778279431e-02f, 1.333521493e-02f,
    9.999999776e-03f, 7.498941850e-03f, 5.623413250e-03f, 4.216964822e-03f, 3.162277630e-03f, 2.371373586e-03f, 1.778279431e-03f, 1.333521446e-03f,
    1.000000047e-03f, 7.498942432e-04f, 5.623413017e-04f, 4.216965172e-04f, 3.162277571e-04f, 2.371373703e-04f, 1.778279402e-04f, 1.333521504e-04f};

__device__ __forceinline__ void rope_cs(int pos, int i, float& c, float& s) {
    const float ang = (float)pos * ROPE_INV[i];
    double r = (double)ang * 0.15915494309189535;
    r -= __builtin_floor(r);
    const float fr = (float)r;
    s = __builtin_amdgcn_sinf(fr); c = __builtin_amdgcn_cosf(fr);
}

struct Args { const float* in[19]; float* out; unsigned char* ws; };
struct Frame {
    LAS unsigned char* lds;
    int tid, lane, wave, vcu, G;
    unsigned char* ws;
};

__device__ __forceinline__ void tr_item(const float* W, int ldw, int K, int N, bf16* WT, int row_off, float scale, LAS float* scr, int item, int lane) {
    const int nblk = N / 32, kb = item / nblk, nb = item % nblk, k0 = 64 * kb, n0 = 32 * nb;
#pragma unroll 8
    for (int i = 0; i < 32; ++i) { const int kk = 2 * i + (lane >> 5); scr[kk * 33 + (lane & 31)] = W[(size_t)(k0 + kk) * ldw + n0 + (lane & 31)]; }
    LDS_WAIT(); asm volatile("" ::: "memory");
    const int c = lane & 7;
#pragma unroll
    for (int j = 0; j < 4; ++j) { const int n = (lane >> 3) + 8 * j; const LAS float* s = scr + (8 * c) * 33 + n;
        v4u o; o.x = pk2(s[0 * 33] * scale, s[1 * 33] * scale); o.y = pk2(s[2 * 33] * scale, s[3 * 33] * scale); o.z = pk2(s[4 * 33] * scale, s[5 * 33] * scale); o.w = pk2(s[6 * 33] * scale, s[7 * 33] * scale);
        *(v4u*)(WT + (size_t)(row_off + n0 + n) * K + k0 + 8 * c) = o; }
    LDS_WAIT(); asm volatile("" ::: "memory");
}
__device__ __forceinline__ void p0_prologue(Frame& F, const Args& A) {
    LAS float* scr = (LAS float*)(F.lds + F.wave * 16384);
    const int gw = F.vcu * NWAVES + F.wave, NGW = F.G * NWAVES;
    unsigned char* ws = F.ws;
    constexpr int I0 = (D / 64) * (INW / 32), I1 = (QRANK / 64) * (QW1 / 32), I2 = (CRANK / 64) * (1024 / 32), I3 = I2, I4 = (D / 64) * (D / 32),
                  I5 = (D / 64) * (256 / 32), I6 = I5, I7 = I4, I8 = I4, I9 = (D / 64) * (FF / 32), I10 = I9, I11 = (FF / 64) * (D / 32), I12 = I11;
    constexpr int NITEMS = I0 + I1 + I2 + I3 + I4 + I5 + I6 + I7 + I8 + I9 + I10 + I11 + I12;
    for (int it = gw; it < NITEMS; it += NGW) {
        int r = it;
        if (r < I0) { tr_item(A.in[1], INW, D, INW, (bf16*)(ws + WS_WIN), 0, 1.f, scr, r, F.lane); continue; } r -= I0;
        if (r < I1) { tr_item(A.in[4], QW1, QRANK, QW1, (bf16*)(ws + WS_WUQ), 0, QSCALE1, scr, r, F.lane); continue; } r -= I1;
        if (r < I2) { tr_item(A.in[5], 1024, CRANK, 1024, (bf16*)(ws + WS_WUK), 0, 1.f, scr, r, F.lane); continue; } r -= I2;
        if (r < I3) { tr_item(A.in[6], 1024, CRANK, 1024, (bf16*)(ws + WS_WUV), 0, 1.f, scr, r, F.lane); continue; } r -= I3;
        if (r < I4) { tr_item(A.in[7], D, D, D, (bf16*)(ws + WS_WO1), 0, 1.f, scr, r, F.lane); continue; } r -= I4;
        if (r < I5) { tr_item(A.in[8], 512, D, 256, (bf16*)(ws + WS_WQK2), 1024, 1.f, scr, r, F.lane); continue; } r -= I5;
        if (r < I6) { tr_item(A.in[8] + 256, 512, D, 256, (bf16*)(ws + WS_WV2), 0, 1.f, scr, r, F.lane); continue; } r -= I6;
        if (r < I7) { tr_item(A.in[9], D, D, D, (bf16*)(ws + WS_WQK2), 0, QSCALE2, scr, r, F.lane); continue; } r -= I7;
        if (r < I8) { tr_item(A.in[11], D, D, D, (bf16*)(ws + WS_WO2), 0, 1.f, scr, r, F.lane); continue; } r -= I8;
        if (r < I9) { tr_item(A.in[13], FF, D, FF, (bf16*)(ws + WS_WUP1), 0, 1.f, scr, r, F.lane); continue; } r -= I9;
        if (r < I10) { tr_item(A.in[13] + (size_t)D * FF, FF, D, FF, (bf16*)(ws + WS_WUP2), 0, 1.f, scr, r, F.lane); continue; } r -= I10;
        if (r < I11) { tr_item(A.in[14], D, FF, D, (bf16*)(ws + WS_WDN1), 0, 1.f, scr, r, F.lane); continue; } r -= I11;
        tr_item(A.in[14] + (size_t)D * FF, D, FF, D, (bf16*)(ws + WS_WDN2), 0, 1.f, scr, r, F.lane);
    }
    { v4u* z = (v4u*)(ws + WS_WIN + (size_t)INW * D * 2); const int n16 = (INWP - INW) * D * 2 / 16;
      for (int i = F.vcu * 512 + F.tid; i < n16; i += F.G * 512) z[i] = (v4u){0u, 0u, 0u, 0u}; }
    { const f32x4* x4 = (const f32x4*)A.in[0]; v4u* o = (v4u*)(ws + WS_BFA); const int n8 = T * D / 8;
      for (int i = F.vcu * 512 + F.tid; i < n8; i += F.G * 512) { const f32x4 a = x4[2 * i], b = x4[2 * i + 1];
          o[i] = (v4u){pk2(a.x, a.y), pk2(a.z, a.w), pk2(b.x, b.y), pk2(b.z, b.w)}; } }
}

__device__ __forceinline__ void p2_latents(Frame& F, const float* gq, const float* gkv) {
    const int gw = F.vcu * NWAVES + F.wave, NGW = F.G * NWAVES, lane = F.lane;
    const float* H = (const float*)(F.ws + WS_H); bf16* CQ = (bf16*)(F.ws + WS_CQ); bf16* CKV = (bf16*)(F.ws + WS_CKV); bf16* KR = (bf16*)(F.ws + WS_KR);
    for (int m = gw; m < T; m += NGW) {
        const float* h = H + (size_t)m * INWP;
        float q[6], kv[4]; float sq = 0.f, sk = 0.f;
#pragma unroll
        for (int j = 0; j < 6; ++j) { q[j] = h[lane + 64 * j]; sq += q[j] * q[j]; }
#pragma unroll
        for (int j = 0; j < 4; ++j) { kv[j] = h[QRANK + lane + 64 * j]; sk += kv[j] * kv[j]; }
        const float rv = h[QRANK + CRANK + lane];
        const float rq = 1.0f / sqrtf(wave_sum(sq) * (1.f / QRANK) + RMS_EPS), rk = 1.0f / sqrtf(wave_sum(sk) * (1.f / CRANK) + RMS_EPS);
#pragma unroll
        for (int j = 0; j < 6; ++j) CQ[(size_t)m * QRANK + lane + 64 * j] = (bf16)f2bf(q[j] * rq * gq[lane + 64 * j]);
#pragma unroll
        for (int j = 0; j < 4; ++j) CKV[(size_t)m * CRANK + lane + 64 * j] = (bf16)f2bf(kv[j] * rk * gkv[lane + 64 * j]);
        float c, s; rope_cs(m & (SEQ - 1), lane & 31, c, s);
        const float pv = __shfl_xor(rv, 32);
        const float o = (lane < 32) ? (rv * c - pv * s) : (pv * s + rv * c);
        KR[(size_t)m * RDIM + lane] = (bf16)f2bf(o);
    }
}
__device__ __forceinline__ void p3b_qrope(Frame& F) {
    const int gw = F.vcu * NWAVES + F.wave, NGW = F.G * NWAVES, lane = F.lane;
    bf16* Q = (bf16*)(F.ws + WS_Q);
    for (int m = gw; m < T; m += NGW) {
        float c, s; rope_cs(m & (SEQ - 1), lane & 31, c, s);
        bf16* qrow = Q + (size_t)m * QW1 + 128 + lane;
        float v[H1];
#pragma unroll
        for (int h = 0; h < H1; ++h) v[h] = bf2f(qrow[h * DQK]);
#pragma unroll
        for (int h = 0; h < H1; ++h) { const float pv = __shfl_xor(v[h], 32); const float o = (lane < 32) ? (v[h] * c - pv * s) : (pv * s + v[h] * c); qrow[h * DQK] = (bf16)f2bf(o); }
    }
}
__device__ __forceinline__ void ln_rows(Frame& F, const float* in, float* out, bf16* outb, const float* g, const float* b) {
    const int gw = F.vcu * NWAVES + F.wave, NGW = F.G * NWAVES, lane = F.lane;
    f32x4 gv[4], bv[4];
#pragma unroll
    for (int j = 0; j < 4; ++j) { gv[j] = ((const f32x4*)g)[lane + 64 * j]; bv[j] = ((const f32x4*)b)[lane + 64 * j]; }
    for (int m = gw; m < T; m += NGW) {
        const f32x4* xr = (const f32x4*)(in + (size_t)m * D) + lane;
        f32x4 v[4]; float s = 0.f;
#pragma unroll
        for (int j = 0; j < 4; ++j) { v[j] = xr[64 * j]; s += (v[j].x + v[j].y) + (v[j].z + v[j].w); }
        const float mean = wave_sum(s) * (1.f / D); float s2 = 0.f;
#pragma unroll
        for (int j = 0; j < 4; ++j) { v[j] = v[j] - mean; s2 += (v[j].x * v[j].x + v[j].y * v[j].y) + (v[j].z * v[j].z + v[j].w * v[j].w); }
        const float rstd = 1.f / sqrtf(wave_sum(s2) * (1.f / D) + LN_EPS);
        f32x4* orow = (f32x4*)(out + (size_t)m * D) + lane;
#pragma unroll
        for (int j = 0; j < 4; ++j) { const f32x4 o = v[j] * rstd * gv[j] + bv[j]; orow[64 * j] = o;
            if (outb) { v2u w; w.x = pk2(o.x, o.y); w.y = pk2(o.z, o.w); ((v2u*)(outb + (size_t)m * D))[lane + 64 * j] = w; } }
    }
}

namespace mla {
constexpr int KP = 400, VP = 136, KBUF = 64 * KP, VBUF = 128 * VP;
constexpr int OFF_K = 0, OFF_V = 2 * KBUF, OFF_WS = OFF_V + 2 * VBUF, LDS_NEED = OFF_WS + NWAVES * 256;
static_assert(LDS_NEED <= RING_BYTES, "mla lds");
__device__ __forceinline__ bf16x8 pack8(const f32x16& p, int b) {
    v4u w; w.x = pk2(p[b], p[b + 1]); w.y = pk2(p[b + 2], p[b + 3]); w.z = pk2(p[b + 4], p[b + 5]); w.w = pk2(p[b + 6], p[b + 7]);
    return __builtin_bit_cast(bf16x8, w);
}
__device__ __forceinline__ void unit(int b, int h, int qb, const bf16* __restrict__ Q, const bf16* __restrict__ KN, const bf16* __restrict__ KR, const bf16* __restrict__ VT, bf16* __restrict__ O, LAS unsigned char* lds) {
    const int tid = threadIdx.x, lane = tid & 63, r32 = lane & 31, hi = lane >> 5; const int wid = __builtin_amdgcn_readfirstlane(tid >> 6);
    const size_t rowbase = (size_t)b * SEQ; const int q0 = qb * 256;
    bf16x8 qf[12];
    { const bf16* qp = Q + (rowbase + q0 + wid * 32 + r32) * QW1 + h * DQK + hi * 8;
#pragma unroll
      for (int d0 = 0; d0 < 12; ++d0) qf[d0] = *(const bf16x8*)(qp + d0 * 16); }
    f32x16 o[4];
#pragma unroll
    for (int d0 = 0; d0 < 4; ++d0)
#pragma unroll
        for (int r = 0; r < 16; ++r) o[d0][r] = 0.f;
    float mhat = 0.f, l = 0.f;
    LAS float* wsf = (LAS float*)(lds + OFF_WS) + wid * 64;
    const int NT = 4 * qb + 4, my_last = 4 * qb + (wid >> 1);
    int kkey[3], kcc[3]; const bf16* ksrc[3];
#pragma unroll
    for (int i = 0; i < 3; ++i) { const int c = tid + 512 * i; kkey[i] = c / 24; kcc[i] = c % 24;
        ksrc[i] = (kcc[i] < 16) ? (KN + (rowbase + kkey[i]) * 1024 + h * 128 + kcc[i] * 8) : (KR + (rowbase + kkey[i]) * RDIM + (kcc[i] - 16) * 8); }
    const size_t kstep0 = (size_t)64 * 1024, kstep1 = (size_t)64 * RDIM;
    int vd[2], vcc[2]; const bf16* vsrc[2];
#pragma unroll
    for (int i = 0; i < 2; ++i) { const int c = tid + 512 * i; vd[i] = c >> 3; vcc[i] = c & 7; vsrc[i] = VT + (size_t)(h * 128 + vd[i]) * T + rowbase + vcc[i] * 8; }
    v4u kst[3], vst[2];
#define MLA_LOAD(t) do { _Pragma("unroll") for (int i = 0; i < 3; ++i) kst[i] = *(const v4u*)(ksrc[i] + (size_t)(t) * ((kcc[i] < 16) ? kstep0 : kstep1)); \
        _Pragma("unroll") for (int i = 0; i < 2; ++i) vst[i] = *(const v4u*)(vsrc[i] + (size_t)(t) * 64); } while (0)
#define MLA_STORE(buf) do { _Pragma("unroll") for (int i = 0; i < 3; ++i) *(LAS v4u*)(lds + OFF_K + (buf) * KBUF + kkey[i] * KP + kcc[i] * 16) = kst[i]; \
        _Pragma("unroll") for (int i = 0; i < 2; ++i) { LAS unsigned char* p = lds + OFF_V + (buf) * VBUF + vd[i] * VP + vcc[i] * 16; \
            *(LAS v2u*)p = (v2u){vst[i].x, vst[i].y}; *(LAS v2u*)(p + 8) = (v2u){vst[i].z, vst[i].w}; } } while (0)
    MLA_LOAD(0); MLA_STORE(0);
    __syncthreads();
    for (int t = 0; t < NT; ++t) {
        const int buf = t & 1;
        if (t + 1 < NT) MLA_LOAD(t + 1);
        if (t <= my_last) {
            const int nh = (t == my_last && !(wid & 1)) ? 1 : 2;
            for (int hh = 0; hh < nh; ++hh) {
            const LAS unsigned char* kb = lds + OFF_K + buf * KBUF + (32 * hh + r32) * KP + hi * 16;
            f32x16 s0;
#pragma unroll
            for (int r = 0; r < 16; ++r) s0[r] = -mhat;
#pragma unroll
            for (int d0 = 0; d0 < 12; ++d0) {
                const bf16x8 a0 = *(const LAS bf16x8*)(kb + d0 * 32);
                s0 = MFMA32(a0, qf[d0], s0);
            }
            if (t == my_last) {
                const int qrel = wid * 32 + r32, kb0 = 64 * t - q0 + 32 * hh + 4 * hi;
#pragma unroll
                for (int r = 0; r < 16; ++r) { const int kv = kb0 + (r & 3) + 8 * (r >> 2); if (kv > qrel) s0[r] = -INFINITY; }
            }
            float rm = s0[0];
#pragma unroll
            for (int r = 1; r < 16; ++r) rm = fmaxf(rm, s0[r]);
            rm = fmaxf(rm, __shfl_xor(rm, 32));
            const bool first = (t == 0 && hh == 0);
            if (first || __any(rm > 8.0f)) {
                const float dl = first ? rm : fmaxf(rm, 0.f);
                mhat += dl;
#pragma unroll
                for (int r = 0; r < 16; ++r) s0[r] -= dl;
                if (!first) {
                    const float f = __builtin_amdgcn_exp2f(-dl); l *= f;
                    if (hi == 0) wsf[r32] = f;
                    LDS_WAIT();
#pragma unroll
                    for (int r = 0; r < 16; ++r) { const float fr = wsf[crow(r, hi)];
#pragma unroll
                        for (int d0 = 0; d0 < 4; ++d0) o[d0][r] *= fr; }
                    LDS_WAIT();
                }
            }
            float sacc = 0.f;
#pragma unroll
            for (int r = 0; r < 16; ++r) { s0[r] = __builtin_amdgcn_exp2f(s0[r]); sacc += s0[r]; }
            l += sacc;
            bf16x8 pa[2]; pa[0] = pack8(s0, 0); pa[1] = pack8(s0, 8);
            const LAS unsigned char* vb = lds + OFF_V + buf * VBUF + r32 * VP + hi * 8 + hh * 64;
#pragma unroll
            for (int d0 = 0; d0 < 4; ++d0)
#pragma unroll
                for (int ks = 0; ks < 2; ++ks) {
                    const v2u lo = *(const LAS v2u*)(vb + d0 * 32 * VP + ks * 32);
                    const v2u h2 = *(const LAS v2u*)(vb + d0 * 32 * VP + ks * 32 + 16);
                    const v4u w = (v4u){lo.x, lo.y, h2.x, h2.y};
                    o[d0] = MFMA32(pa[ks], __builtin_bit_cast(bf16x8, w), o[d0]);
                }
            }
        }
        if (t + 1 < NT) MLA_STORE(buf ^ 1);
        __syncthreads();
    }
#undef MLA_LOAD
#undef MLA_STORE
    l += __shfl_xor(l, 32);
    if (hi == 0) wsf[r32] = 1.0f / l;
    LDS_WAIT();
    float rl[16];
#pragma unroll
    for (int r = 0; r < 16; ++r) rl[r] = wsf[crow(r, hi)];
    LDS_WAIT();
    bf16* Ow = O + (rowbase + q0 + wid * 32) * 1024 + h * 128 + r32;
#pragma unroll
    for (int r = 0; r < 16; ++r) { const int orow = crow(r, hi);
#pragma unroll
        for (int d0 = 0; d0 < 4; ++d0) Ow[(size_t)orow * 1024 + d0 * 32] = (bf16)f2bf(o[d0][r] * rl[r]); }
}
__device__ __forceinline__ void phase(Frame& F) {
    const bf16* Q = (const bf16*)(F.ws + WS_Q); const bf16* KN = (const bf16*)(F.ws + WS_KN); const bf16* KR = (const bf16*)(F.ws + WS_KR); const bf16* VT = (const bf16*)(F.ws + WS_VT);
    bf16* O = (bf16*)(F.ws + WS_O);
    const bool bal = (F.G == 256);
    const int nu = bal ? 4 : (BATCH * H1 * 32 - F.vcu + F.G - 1) / F.G;
    for (int i = 0; i < nu; ++i) {
        int bh, qb;
        if (bal) { const int s = F.vcu & 7; bh = F.vcu >> 3; qb = (i == 0) ? s : (i == 1) ? 15 - s : (i == 2) ? 16 + s : 31 - s; }
        else { const int u = F.vcu + i * F.G; bh = u >> 5; qb = u & 31; }
        unit(bh / H1, bh % H1, qb, Q, KN, KR, VT, O, F.lds);
    }
}
}

namespace swa {
constexpr int KP = 144, VP = 520;
constexpr int OFF_K = 0, OFF_V = 256 * KP, OFF_BT = OFF_V + 64 * VP, OFF_WS = OFF_BT + 1024, LDS_NEED = OFF_WS + NWAVES * 256;
static_assert(LDS_NEED <= RING_BYTES, "swa lds");
__device__ __forceinline__ int t5_bucket(int n) {
    if (n < 16) return n;
    const int v = 16 + (int)(__log2f((float)n * (1.f / 16.f)) * (16.f / 3.f));
    return v < 31 ? v : 31;
}
__device__ __forceinline__ void unit(int b, int n, int kvh, int p, const bf16* __restrict__ QK, const bf16* __restrict__ VT, bf16* __restrict__ O, const float* __restrict__ rel_bias, const float* __restrict__ sinks, LAS unsigned char* lds) {
    const int tid = threadIdx.x, lane = tid & 63, r32 = lane & 31, hi = lane >> 5; const int wid = __builtin_amdgcn_readfirstlane(tid >> 6);
    const long r0 = (long)b * SEQ + 128 * (n - 1);
#pragma unroll
    for (int i = 0; i < 4; ++i) { const int c = tid + 512 * i, key = c >> 3, cc = c & 7;
        v4u v = (v4u){0u, 0u, 0u, 0u};
        if (n > 0 || key >= 128) v = *(const v4u*)(QK + (size_t)(r0 + key) * QKW2 + 1024 + kvh * 64 + cc * 8);
        *(LAS v4u*)(lds + OFF_K + key * KP + cc * 16) = v; }
#pragma unroll
    for (int i = 0; i < 4; ++i) { const int c = tid + 512 * i, d = c >> 5, cc = c & 31;
        v4u v = (v4u){0u, 0u, 0u, 0u};
        if (n > 0 || cc >= 16) v = *(const v4u*)(VT + (size_t)(kvh * 64 + d) * T + r0 + cc * 8);
        LAS unsigned char* pp = lds + OFF_V + d * VP + cc * 16;
        *(LAS v2u*)pp = (v2u){v.x, v.y}; *(LAS v2u*)(pp + 8) = (v2u){v.z, v.w}; }
    LAS float* bt = (LAS float*)(lds + OFF_BT);
    if (tid < 256) { const int hs = tid >> 7, dist = tid & 127; bt[tid] = rel_bias[t5_bucket(dist) * H2 + kvh * 4 + p * 2 + hs] * LOG2E; }
    __syncthreads();
    const int hs = wid >> 2, wq = wid & 3, head = kvh * 4 + p * 2 + hs;
    const size_t qrow = (size_t)b * SEQ + 128 * n + 32 * wq;
    bf16x8 qf[4];
    { const bf16* qp = QK + (qrow + r32) * QKW2 + head * 64 + hi * 8;
#pragma unroll
      for (int d0 = 0; d0 < 4; ++d0) qf[d0] = *(const bf16x8*)(qp + d0 * 16); }
    f32x16 s[5];
    const float sinkl = sinks[head] * LOG2E;
    float m = sinkl;
    const LAS float* btw = bt + hs * 128;
#pragma unroll
    for (int kb = 0; kb < 5; ++kb) {
        const int jb = wq + kb;
        const LAS unsigned char* kp = lds + OFF_K + (32 * jb + r32) * KP + hi * 16;
#pragma unroll
        for (int r = 0; r < 16; ++r) s[kb][r] = 0.f;
#pragma unroll
        for (int d0 = 0; d0 < 4; ++d0) { const bf16x8 a = *(const LAS bf16x8*)(kp + d0 * 32); s[kb] = MFMA32(a, qf[d0], s[kb]); }
#pragma unroll
        for (int r = 0; r < 16; ++r) { const int j = 32 * jb + crow(r, hi), dist = 32 * wq + r32 + 128 - j;
            const bool valid = (dist >= 0) && (dist < 128) && (n > 0 || j >= 128);
            const float bias = btw[dist & 127];
            s[kb][r] = valid ? (s[kb][r] + bias) : -INFINITY; m = fmaxf(m, s[kb][r]); }
    }
    m = fmaxf(m, __shfl_xor(m, 32));
    float lsum = 0.f;
#pragma unroll
    for (int kb = 0; kb < 5; ++kb)
#pragma unroll
        for (int r = 0; r < 16; ++r) { s[kb][r] = __builtin_amdgcn_exp2f(s[kb][r] - m); lsum += s[kb][r]; }
    lsum += __shfl_xor(lsum, 32);
    const float denom = lsum + __builtin_amdgcn_exp2f(sinkl - m);
    f32x16 o[2];
#pragma unroll
    for (int d0 = 0; d0 < 2; ++d0)
#pragma unroll
        for (int r = 0; r < 16; ++r) o[d0][r] = 0.f;
#pragma unroll
    for (int kb = 0; kb < 5; ++kb) {
        const int jb = wq + kb;
        bf16x8 pa[2]; pa[0] = mla::pack8(s[kb], 0); pa[1] = mla::pack8(s[kb], 8);
#pragma unroll
        for (int d0 = 0; d0 < 2; ++d0)
#pragma unroll
            for (int ks = 0; ks < 2; ++ks) {
                const LAS unsigned char* vb = lds + OFF_V + (32 * d0 + r32) * VP + (32 * jb + 16 * ks + 4 * hi) * 2;
                const v2u lo = *(const LAS v2u*)vb; const v2u h2 = *(const LAS v2u*)(vb + 16);
                const v4u w = (v4u){lo.x, lo.y, h2.x, h2.y};
                o[d0] = MFMA32(pa[ks], __builtin_bit_cast(bf16x8, w), o[d0]);
            }
    }
    LAS float* wsf = (LAS float*)(lds + OFF_WS) + wid * 64;
    if (hi == 0) wsf[r32] = 1.0f / denom;
    LDS_WAIT();
    float rl[16];
#pragma unroll
    for (int r = 0; r < 16; ++r) rl[r] = wsf[crow(r, hi)];
    LDS_WAIT();
    bf16* Ow = O + qrow * 1024 + head * 64 + r32;
#pragma unroll
    for (int r = 0; r < 16; ++r) { const int orow = crow(r, hi);
#pragma unroll
        for (int d0 = 0; d0 < 2; ++d0) Ow[(size_t)orow * 1024 + d0 * 32] = (bf16)f2bf(o[d0][r] * rl[r]); }
    __syncthreads();
}
__device__ __forceinline__ void phase(Frame& F, const float* rel_bias, const float* sinks) {
    const bf16* QK = (const bf16*)(F.ws + WS_QK2); const bf16* VT = (const bf16*)(F.ws + WS_V2T); bf16* O = (bf16*)(F.ws + WS_O2);
    for (int u = F.vcu; u < BATCH * 64 * KVH2 * 2; u += F.G) { const int p = u & 1, kvh = (u >> 1) & 3, n = (u >> 3) & 63, b = u >> 9; unit(b, n, kvh, p, QK, VT, O, rel_bias, sinks, F.lds); }
}
}

__global__ void __launch_bounds__(NWAVES * 64, 2) fwd_megakernel(Args args) {
    extern __shared__ __attribute__((aligned(16))) unsigned char lds_raw[];
    cg::grid_group grid = cg::this_grid();
    Frame F;
    F.lds = (LAS unsigned char*)lds_raw;
    F.tid = threadIdx.x; F.lane = F.tid & 63; F.wave = __builtin_amdgcn_readfirstlane(F.tid >> 6);
    F.G = gridDim.x; { const int bx = blockIdx.x; F.vcu = (F.G % 8 == 0) ? (bx % 8) * (F.G / 8) + bx / 8 : bx; }
    F.ws = args.ws;
    unsigned char* ws = args.ws;
    bf16* BFA = (bf16*)(ws + WS_BFA); float* F32A = (float*)(ws + WS_F32A); bf16* HB = (bf16*)(ws + WS_HB);
    using pg8::Gemm; using pg8::StaticOrder; using pg8::EpiBf16; using pg8::EpiF32;
#define GEMM_BF16(ACT, Aptr, Bptr, M_, N_, K_, Optr, ldc_, scols, sstride, sc0) do { Gemm g{(const pg8::bf16_t*)(Aptr), (const pg8::bf16_t*)(Bptr), M_, N_, K_}; StaticOrder S; S.init(M_, N_, F.G, (int)blockIdx.x); \
        EpiBf16<ACT> E{(pg8::bf16_t*)(Optr), ldc_, nullptr, scols, sstride, sc0}; pg8::gemm_phase<EpiBf16<ACT>, StaticOrder, true, true>(F.lds, g, S, E); } while (0)
#define GEMM_F32(Aptr, Bptr, M_, N_, K_, Optr, ldc_, resptr, alpha_) do { Gemm g{(const pg8::bf16_t*)(Aptr), (const pg8::bf16_t*)(Bptr), M_, N_, K_}; StaticOrder S; S.init(M_, N_, F.G, (int)blockIdx.x); \
        EpiF32 E{(float*)(Optr), ldc_, resptr, alpha_}; pg8::gemm_phase<EpiF32, StaticOrder, true, true>(F.lds, g, S, E); } while (0)

#ifndef SKIP_P0
    p0_prologue(F, args);
#endif
    grid.sync();
    GEMM_F32(BFA, ws + WS_WIN, T, INWP, D, ws + WS_H, INWP, (const float*)nullptr, 0.f);
    grid.sync();
    p2_latents(F, args.in[2], args.in[3]);
    grid.sync();
    GEMM_BF16(0, ws + WS_CQ, ws + WS_WUQ, T, QW1, QRANK, ws + WS_Q, QW1, 0, (size_t)0, 1.f);
    GEMM_BF16(0, ws + WS_CKV, ws + WS_WUK, T, 1024, CRANK, ws + WS_KN, 1024, 0, (size_t)0, 1.f);
    GEMM_BF16(0, ws + WS_WUV, ws + WS_CKV, 1024, T, CRANK, ws + WS_VT, T, 0, (size_t)0, 1.f);
    grid.sync();
    p3b_qrope(F);
    grid.sync();
#ifndef SKIP_MLA
    mla::phase(F);
#endif
    grid.sync();
    GEMM_F32(ws + WS_O, ws + WS_WO1, T, D, D, F32A, D, args.in[0], ALPHA);
    grid.sync();
    ln_rows(F, F32A, F32A, BFA, args.in[15], args.in[16]);
    grid.sync();
    GEMM_BF16(2, BFA, ws + WS_WUP1, T, FF, D, HB, FF, 0, (size_t)0, 1.f);
    grid.sync();
    GEMM_F32(HB, ws + WS_WDN1, T, D, FF, F32A, D, (const float*)F32A, ALPHA);
    grid.sync();
    ln_rows(F, F32A, F32A, BFA, args.in[17], args.in[18]);
    grid.sync();
    GEMM_BF16(0, BFA, ws + WS_WQK2, T, QKW2, D, ws + WS_QK2, QKW2, 0, (size_t)0, 1.f);
    GEMM_BF16(0, ws + WS_WV2, BFA, 256, T, D, ws + WS_V2T, T, 0, (size_t)0, 1.f);
    grid.sync();
#ifndef SKIP_SWA
    swa::phase(F, args.in[12], args.in[10]);
#endif
    grid.sync();
    GEMM_F32(ws + WS_O2, ws + WS_WO2, T, D, D, F32A, D, (const float*)F32A, ALPHA);
    grid.sync();
    ln_rows(F, F32A, F32A, BFA, args.in[15] + D, args.in[16] + D);
    grid.sync();
    GEMM_BF16(2, BFA, ws + WS_WUP2, T, FF, D, HB, FF, 0, (size_t)0, 1.f);
    grid.sync();
    GEMM_F32(HB, ws + WS_WDN2, T, D, FF, args.out, D, (const float*)F32A, ALPHA);
    grid.sync();
    ln_rows(F, args.out, args.out, (bf16*)nullptr, args.in[17] + D, args.in[18] + D);
}

extern "C" void kernel_launch(void* const* d_in, const int* in_sizes, int n_in, void* d_out, int out_size, void* d_ws, size_t ws_size, hipStream_t stream) {
    static int grid = 0;
    if (grid == 0) {
        if (n_in != 19 || in_sizes[0] != T * D || out_size != T * D || ws_size < WS_END) { fprintf(stderr, "kernel_launch: unexpected shapes (n_in %d, in0 %d, out %d, ws %zu)\n", n_in, n_in > 0 ? in_sizes[0] : -1, out_size, ws_size); grid = -1; return; }
        int dev = 0, cus = 0, per_cu = 0;
        if (hipGetDevice(&dev) != hipSuccess || hipDeviceGetAttribute(&cus, hipDeviceAttributeMultiprocessorCount, dev) != hipSuccess) { grid = -1; return; }
        if (hipFuncSetAttribute((const void*)fwd_megakernel, hipFuncAttributeMaxDynamicSharedMemorySize, LDS_BYTES) != hipSuccess) { fprintf(stderr, "kernel_launch: hipFuncSetAttribute failed\n"); grid = -1; return; }
        if (hipOccupancyMaxActiveBlocksPerMultiprocessor(&per_cu, (const void*)fwd_megakernel, NWAVES * 64, LDS_BYTES) != hipSuccess || per_cu < 1) per_cu = 1;
        (void)hipGetLastError();
        grid = cus * per_cu;
    }
    if (grid < 0) return;
    Args a{};
    for (int i = 0; i < 19; ++i) a.in[i] = (const float*)d_in[i];
    a.out = (float*)d_out; a.ws = (unsigned char*)d_ws;
    void* kargs[] = {&a};
    hipError_t e = hipLaunchCooperativeKernel((const void*)fwd_megakernel, dim3(grid), dim3(NWAVES * 64), kargs, LDS_BYTES, stream);
    if (e != hipSuccess) fprintf(stderr, "kernel_launch: cooperative launch failed: %s (grid %d)\n", hipGetErrorString(e), grid);
}
```

```cpp
#include <hip/hip_runtime.h>
#include <cstdio>
#include <cstdint>
#include <hip/hip_cooperative_groups.h>
namespace pg8 {
#define PG8_LAS __attribute__((address_space(3)))
typedef unsigned short bf16_t;
typedef short bf16x8 __attribute__((ext_vector_type(8)));
typedef float f32x4 __attribute__((ext_vector_type(4)));
typedef unsigned u32x4 __attribute__((ext_vector_type(4)));
constexpr int BM = 256, BK = 64, HALF = 128, HTB = HALF * BK * 2  , STAGE_BYTES = 8 * HTB, NXCD = 8, WGM = 8;

__host__ __device__ __forceinline__ int lds_byte(int r, int c) { const int st = (r >> 4) * 2 + (c >> 5), rr = r & 15, cc = c & 31, ob = rr * 64 + cc * 2; return st * 1024 + (ob ^ (((ob >> 9) & 1) << 5)); }
__host__ __device__ __forceinline__ void stage_rc(int b, int& R, int& C) { const int st = b / 1024, sb = b % 1024, swz = sb ^ (((sb >> 9) & 1) << 5); R = (st >> 1) * 16 + swz / 64; C = (st & 1) * 32 + (swz % 64) / 2; }
__host__ __device__ __forceinline__ int perm32(int rho) { const int n = rho >> 4, i = rho & 15; return 8 * (i >> 2) + 4 * n + (i & 3); }

struct Unit { int pm, pn; };
struct Gemm { const bf16_t* A; const bf16_t* Bt; int M, N, K; };

struct StaticOrder {
    int nM, nN, nwg, G, c;
    __host__ __device__ void init(int M, int N, int G_, int c_) { nM = M / BM; nN = N / BM; nwg = nM * nN; G = G_; c = c_; }
    __host__ __device__ bool next(int i, Unit& u) const {
        const long L = (long)i * G + c; if (L >= nwg) return false;
        int wgid = (int)L; { const int q = nwg / NXCD, r = nwg % NXCD, xcd = wgid % NXCD, off = wgid / NXCD; wgid = (xcd < r ? xcd * (q + 1) : r * (q + 1) + (xcd - r) * q) + off; }
        const int nig = WGM * nN, gid = wgid / nig, fm = gid * WGM, gsz = (nM - fm) < WGM ? (nM - fm) : WGM;
        u.pm = fm + ((wgid % nig) % gsz); u.pn = (wgid % nig) / gsz; return true;
    }
    __device__ __forceinline__ void a_ready(const Unit&) const {}
    __device__ __forceinline__ void done(const Unit&) const {}
};

typedef _Float16 f16x8 __attribute__((ext_vector_type(8)));
typedef _Float16 f16x2 __attribute__((ext_vector_type(2)));
__device__ __forceinline__ unsigned cvt_pk_bf16(float lo, float hi) { const f16x2 h = {(_Float16)lo, (_Float16)hi}; return __builtin_bit_cast(unsigned, h); }
typedef float f32x2 __attribute__((ext_vector_type(2)));
__device__ __forceinline__ f32x2 gelu_pk(f32x2 v) {
    const f32x2 av = __builtin_elementwise_abs(v), d = av * 0.2316418882f + 1.0f;
    f32x2 t; t.x = __builtin_amdgcn_rcpf(d.x); t.y = __builtin_amdgcn_rcpf(d.y);
    f32x2 q = t * 0.5307027145f + (-0.7265760135f); q = q * t + 0.7107068705f; q = q * t + (-0.142248368f); q = q * t + 0.127414796f; q = q * t;
    const f32x2 s = (v * v) * (-0.72134752044f);
    f32x2 e; e.x = __builtin_amdgcn_exp2f(s.x); e.y = __builtin_amdgcn_exp2f(s.y);
    const f32x2 m = v * (q * e), r = v - m;
    f32x2 o; o.x = v.x < 0.f ? m.x : r.x; o.y = v.y < 0.f ? m.y : r.y; return o;
}

template <int ACT  > struct EpiBf16 {
    static constexpr bool PERM = true, AFTER_DRAIN = false; static_assert(ACT == 0 || ACT == 1 || ACT == 2, "EpiBf16: ACT is 0 (none), 1 (gelu_pk) or 2 (squared relu)");
    bf16_t* O; int ldc; const float* bias; int split_cols; size_t split_stride; float scale0;
    __device__ __forceinline__ void operator()(const f32x4 (&acc)[2][2][4][2], const Unit& u, int wr, int wc, int fr, int fq) const {
        const int row0 = u.pm * BM + wr * 64 + fr; int colt = u.pn * BM; bf16_t* base = O;
        float sc = 1.f; if (split_cols) { const int t = colt / split_cols; base += (size_t)t * split_stride; colt -= t * split_cols; if (t == 0) sc = scale0; }
        const int col0 = colt + wc * 32 + 8 * fq, bcol0 = u.pn * BM + wc * 32 + 8 * fq;
        f32x4 bv[2][2];
#pragma unroll
        for (int bj = 0; bj < 2; ++bj)
#pragma unroll
            for (int n = 0; n < 2; ++n) bv[bj][n] = bias ? *(const f32x4*)(bias + bcol0 + bj * HALF + 4 * n) : (f32x4){0.f, 0.f, 0.f, 0.f};
#pragma unroll
        for (int ai = 0; ai < 2; ++ai)
#pragma unroll
            for (int m = 0; m < 4; ++m) { bf16_t* rowp = base + (size_t)(row0 + ai * HALF + m * 16) * ldc + col0;
#pragma unroll
                for (int bj = 0; bj < 2; ++bj) { f32x4 v0 = acc[ai][bj][m][0] + bv[bj][0], v1 = acc[ai][bj][m][1] + bv[bj][1];
                    if (ACT == 1) { f32x2 a = gelu_pk((f32x2){v0[0], v0[1]}), b = gelu_pk((f32x2){v0[2], v0[3]}), c = gelu_pk((f32x2){v1[0], v1[1]}), d = gelu_pk((f32x2){v1[2], v1[3]});
                        v0 = (f32x4){a.x, a.y, b.x, b.y}; v1 = (f32x4){c.x, c.y, d.x, d.y}; }
                    if (ACT == 2) { _Pragma("unroll") for (int e = 0; e < 4; ++e) { const float a0 = fmaxf(v0[e], 0.f), a1 = fmaxf(v1[e], 0.f); v0[e] = a0 * a0; v1[e] = a1 * a1; } }
                    v0 = v0 * sc; v1 = v1 * sc; u32x4 w; w.x = cvt_pk_bf16(v0[0], v0[1]); w.y = cvt_pk_bf16(v0[2], v0[3]); w.z = cvt_pk_bf16(v1[0], v1[1]); w.w = cvt_pk_bf16(v1[2], v1[3]);
                    *(u32x4*)(rowp + bj * HALF) = w; } }
    }
};

struct PanelStats {
    unsigned* xbuf;
    unsigned* cnt;
    unsigned* tmo;
    int ntn; float eps;
    unsigned code;
    __device__ __forceinline__ bool run(const f32x4 (&v)[2][2][4][2], const Unit& u, int wr, int wc, int fr, int fq, PG8_LAS unsigned char* lds, int wid, int lane) const {
        typedef float f32x2v __attribute__((ext_vector_type(2)));
        PG8_LAS f32x2v* P = (PG8_LAS f32x2v*)lds;
        PG8_LAS f32x2v* S = (PG8_LAS f32x2v*)(lds + 8192);
        PG8_LAS unsigned* flag = (PG8_LAS unsigned*)(lds + 8192 + 2048);
#pragma unroll
        for (int ai = 0; ai < 2; ++ai)
#pragma unroll
            for (int m = 0; m < 4; ++m) {
                float s = 0.f;
#pragma unroll
                for (int bj = 0; bj < 2; ++bj)
#pragma unroll
                    for (int n = 0; n < 2; ++n) { const f32x4 x = v[ai][bj][m][n]; s += (x[0] + x[1]) + (x[2] + x[3]); }
                s += __shfl_xor(s, 16); s += __shfl_xor(s, 32);
                const float mw = s * (1.0f / 64.0f); float q = 0.f;
#pragma unroll
                for (int bj = 0; bj < 2; ++bj)
#pragma unroll
                    for (int n = 0; n < 2; ++n) { const f32x4 d = v[ai][bj][m][n] - mw; q += (d[0] * d[0] + d[1] * d[1]) + (d[2] * d[2] + d[3] * d[3]); }
                q += __shfl_xor(q, 16); q += __shfl_xor(q, 32);
                if (fq == 0) P[(ai * HALF + wr * 64 + m * 16 + fr) * 4 + wc] = (f32x2v){mw, q};
            }
        asm volatile("s_waitcnt lgkmcnt(0)" ::: "memory"); __builtin_amdgcn_s_barrier(); asm volatile("" ::: "memory");
#if defined(BROKEN_EXCHANGE_NO_WAIT)
#warning BROKEN CONTROL BUILD: the row-statistics exchange does not wait; results are wrong by design
        if (blockIdx.x >= 64) { const long long t0_ = clock64(); while (clock64() - t0_ < 60000) __builtin_amdgcn_s_sleep(8); }
#endif
        const int row = wid * 32 + (lane & 31);
        if (lane < 32) {
            const f32x2v a = P[row * 4 + 0], b = P[row * 4 + 1], c = P[row * 4 + 2], d = P[row * 4 + 3];
            const float mt = (a.x + b.x + c.x + d.x) * 0.25f;
            const float da = a.x - mt, db = b.x - mt, dc = c.x - mt, dd = d.x - mt;
            const float m2 = (a.y + b.y) + (c.y + d.y) + 64.0f * ((da * da + db * db) + (dc * dc + dd * dd));
            unsigned long long* slot = (unsigned long long*)xbuf + ((size_t)(u.pm * BM + row) * 4 + u.pn);
            __hip_atomic_store(slot, ((unsigned long long)__float_as_uint(m2) << 32) | __float_as_uint(mt), __ATOMIC_RELAXED, __HIP_MEMORY_SCOPE_AGENT);
        }
        asm volatile("s_waitcnt vmcnt(0)" ::: "memory");
        if (lane == 0) __hip_atomic_fetch_add(cnt + 64 * u.pm, 1u, __ATOMIC_RELAXED, __HIP_MEMORY_SCOPE_AGENT);
        if (wid == 0) {
            bool dead = false; const unsigned long long t0 = __builtin_amdgcn_s_memrealtime(); const unsigned want = 8u * (unsigned)ntn;
            for (;;) {
#if defined(BROKEN_EXCHANGE_NO_WAIT)
                break;
#endif
                if ((unsigned)__builtin_amdgcn_readfirstlane(__hip_atomic_load(cnt + 64 * u.pm, __ATOMIC_RELAXED, __HIP_MEMORY_SCOPE_AGENT)) >= want) break;
                if (__builtin_amdgcn_s_memrealtime() - t0 > 2000000ull) {
                    if (lane == 0) { unsigned expect = 0u; __hip_atomic_compare_exchange_strong(tmo + 1, &expect, code | (unsigned)(u.pm & 0xff), __ATOMIC_RELAXED, __ATOMIC_RELAXED, __HIP_MEMORY_SCOPE_AGENT);
                                     __hip_atomic_store(tmo, 1u, __ATOMIC_RELAXED, __HIP_MEMORY_SCOPE_AGENT); }
                    dead = true; break; }
                __builtin_amdgcn_s_sleep(2);
            }
            __builtin_amdgcn_fence(__ATOMIC_ACQUIRE, "agent");
            if (lane == 0) flag[0] = dead ? 1u : 0u;
        }
        asm volatile("s_waitcnt vmcnt(0) lgkmcnt(0)" ::: "memory"); __builtin_amdgcn_s_barrier(); asm volatile("" ::: "memory");
        const bool bad = flag[0] != 0u;
        if (lane < 32) {
            const unsigned long long* slot = (const unsigned long long*)xbuf + (size_t)(u.pm * BM + row) * 4; float mt[4], m2[4]; float ms = 0.f;
#pragma unroll
            for (int t = 0; t < 4; ++t) { if (t < ntn) { const unsigned long long w = __hip_atomic_load(slot + t, __ATOMIC_RELAXED, __HIP_MEMORY_SCOPE_AGENT); mt[t] = __uint_as_float((unsigned)w); m2[t] = __uint_as_float((unsigned)(w >> 32)); } else { mt[t] = 0.f; m2[t] = 0.f; } ms += mt[t]; }
            const float mean = ms / (float)ntn; float q = 0.f;
#pragma unroll
            for (int t = 0; t < 4; ++t) if (t < ntn) { const float dm = mt[t] - mean; q += m2[t] + 256.0f * dm * dm; }
            S[row] = (f32x2v){mean, 1.0f / sqrtf(q / (256.0f * (float)ntn) + eps)};
        }
        asm volatile("s_waitcnt lgkmcnt(0)" ::: "memory"); __builtin_amdgcn_s_barrier(); asm volatile("" ::: "memory");
        return bad;
    }
};
struct EpiLnRes {
    static constexpr bool PERM = false, AFTER_DRAIN = true;
    const float* base; float* out; int ldc; const float* bias; PanelStats st; unsigned poison;
    __device__ __forceinline__ void fused(f32x4 (&acc)[2][2][4][2], const Unit& u, int wr, int wc, int fr, int fq, PG8_LAS unsigned char* lds, int wid, int lane) const {
        typedef float f32x2v __attribute__((ext_vector_type(2)));
        const PG8_LAS f32x2v* S = (const PG8_LAS f32x2v*)(lds + 8192);
        const int col0 = u.pn * BM + wc * 32 + 4 * fq;
#pragma unroll
        for (int bj = 0; bj < 2; ++bj)
#pragma unroll
            for (int n = 0; n < 2; ++n) { const f32x4 bv = bias ? *(const f32x4*)(bias + col0 + bj * HALF + n * 16) : (f32x4){0.f, 0.f, 0.f, 0.f};
#pragma unroll
                for (int ai = 0; ai < 2; ++ai)
#pragma unroll
                    for (int m = 0; m < 4; ++m) acc[ai][bj][m][n] += bv; }
        f32x4 pre[4][2][2];
#pragma unroll
        for (int m = 0; m < 4; ++m) { const size_t off = (size_t)(u.pm * BM + wr * 64 + m * 16 + fr) * ldc + col0;
#pragma unroll
            for (int bj = 0; bj < 2; ++bj)
#pragma unroll
                for (int n = 0; n < 2; ++n) pre[m][bj][n] = *(const f32x4*)(base + off + bj * HALF + n * 16); }
        const bool bad = st.run(acc, u, wr, wc, fr, fq, lds, wid, lane) || poison != 0u;
        const float qnan = __builtin_nanf("");
#pragma unroll
        for (int ai = 0; ai < 2; ++ai)
#pragma unroll
            for (int m = 0; m < 4; ++m) { const int r = ai * HALF + wr * 64 + m * 16 + fr; const f32x2v sr = S[r]; const size_t off = (size_t)(u.pm * BM + r) * ldc + col0;
#pragma unroll
                for (int bj = 0; bj < 2; ++bj)
#pragma unroll
                    for (int n = 0; n < 2; ++n) { const f32x4 bs = ai == 0 ? pre[m][bj][n] : *(const f32x4*)(base + off + bj * HALF + n * 16); f32x4 o = bs + (acc[ai][bj][m][n] - sr.x) * sr.y;
                        if (bad) o = (f32x4){qnan, qnan, qnan, qnan}; *(f32x4*)(out + off + bj * HALF + n * 16) = o; }
                if (m & 1) asm volatile("" ::: "memory"); }
    }
};
struct EpiLnResLn {
    static constexpr bool PERM = false, AFTER_DRAIN = true;
    const float* base; float* out; bf16_t* xn; int ldc; const float* bias; PanelStats st1, st2; unsigned poison;
    __device__ __forceinline__ void fused(f32x4 (&acc)[2][2][4][2], const Unit& u, int wr, int wc, int fr, int fq, PG8_LAS unsigned char* lds, int wid, int lane) const {
        typedef float f32x2v __attribute__((ext_vector_type(2))); typedef unsigned u32x2v __attribute__((ext_vector_type(2)));
        const PG8_LAS f32x2v* S = (const PG8_LAS f32x2v*)(lds + 8192);
        const int col0 = u.pn * BM + wc * 32 + 4 * fq;
#pragma unroll
        for (int bj = 0; bj < 2; ++bj)
#pragma unroll
            for (int n = 0; n < 2; ++n) { const f32x4 bv = bias ? *(const f32x4*)(bias + col0 + bj * HALF + n * 16) : (f32x4){0.f, 0.f, 0.f, 0.f};
#pragma unroll
                for (int ai = 0; ai < 2; ++ai)
#pragma unroll
                    for (int m = 0; m < 4; ++m) acc[ai][bj][m][n] += bv; }
        bool bad = st1.run(acc, u, wr, wc, fr, fq, lds, wid, lane) || poison != 0u;
        const float qnan = __builtin_nanf("");
#pragma unroll
        for (int ai = 0; ai < 2; ++ai)
#pragma unroll
            for (int m = 0; m < 4; ++m) { const int r = ai * HALF + wr * 64 + m * 16 + fr; const f32x2v sr = S[r]; const size_t off = (size_t)(u.pm * BM + r) * ldc + col0;
#pragma unroll
                for (int bj = 0; bj < 2; ++bj)
#pragma unroll
                    for (int n = 0; n < 2; ++n) { const f32x4 bs = *(const f32x4*)(base + off + bj * HALF + n * 16); acc[ai][bj][m][n] = bs + (acc[ai][bj][m][n] - sr.x) * sr.y; }
                asm volatile("" : "+v"(acc[ai][0][m][0]), "+v"(acc[ai][0][m][1]), "+v"(acc[ai][1][m][0]), "+v"(acc[ai][1][m][1]));
                if (m & 1) asm volatile("" ::: "memory"); }
        const bool bad1 = bad;
        bad = st2.run(acc, u, wr, wc, fr, fq, lds, wid, lane) || bad;
#pragma unroll
        for (int ai = 0; ai < 2; ++ai)
#pragma unroll
            for (int m = 0; m < 4; ++m) { const int r = ai * HALF + wr * 64 + m * 16 + fr; const f32x2v sr = S[r]; const size_t off = (size_t)(u.pm * BM + r) * ldc + col0;
#pragma unroll
                for (int bj = 0; bj < 2; ++bj)
#pragma unroll
                    for (int n = 0; n < 2; ++n) { const f32x4 x1 = acc[ai][bj][m][n]; *(f32x4*)(out + off + bj * HALF + n * 16) = bad1 ? (f32x4){qnan, qnan, qnan, qnan} : x1;
                        const f32x4 o = (x1 - sr.x) * sr.y; u32x2v w; w.x = cvt_pk_bf16(o[0], o[1]); w.y = cvt_pk_bf16(o[2], o[3]);
                        if (bad) { w.x = 0x7fc07fc0u; w.y = 0x7fc07fc0u; } *(u32x2v*)(xn + off + bj * HALF + n * 16) = w; }
                asm volatile("" ::: "memory"); }
    }
};

template <class Epi, class Sched, bool ALIGN_EPI = false, bool SP2 = false>
__device__ __forceinline__ void gemm_phase(PG8_LAS unsigned char* lds, const Gemm g, const Sched& S, const Epi& E) {
    const int tid = threadIdx.x, wid = __builtin_amdgcn_readfirstlane(tid >> 6), lane = tid & 63, wr = wid >> 2, wc = wid & 3, fr = lane & 15, fq = lane >> 4;
    const int K = g.K, nt = K / BK;
    unsigned voffA[2], voffB[2];
#pragma unroll
    for (int i = 0; i < 2; ++i) { int R, C; stage_rc(tid * 16 + i * 8192, R, C); const int Rb = Epi::PERM ? ((R & ~31) + perm32(R & 31)) : R;
        voffA[i] = (unsigned)(R * K + C) * 2u; voffB[i] = (unsigned)(Rb * K + C) * 2u; }
    const size_t kstep = (size_t)(BK * 2);
    const size_t hstep = (size_t)HALF * K * 2;
    const size_t tstep = 2 * hstep;
    const unsigned ldsw = (unsigned)wid * 1024u;
    const int aoff = lds_byte(wr * 64 + fr, fq * 8), boff = lds_byte(wc * 32 + fr, fq * 8);
#define PG8_SA(b, h) (((b) * 2 + (h)) * HTB)
#define PG8_SB(b, h) ((4 + (b) * 2 + (h)) * HTB)
#define PG8_STAGE(bufoff, gbase, voff) do { _Pragma("unroll") for (int _i = 0; _i < 2; ++_i) \
        __builtin_amdgcn_global_load_lds((const unsigned*)((const char*)(gbase) + (voff)[_i]), (PG8_LAS unsigned*)(lds + (bufoff) + ldsw + _i * 8192), 16, 0, 0); } while (0)
#define PG8_LDA(dst, b, h) do { _Pragma("unroll") for (int m = 0; m < 4; ++m) _Pragma("unroll") for (int k = 0; k < 2; ++k) dst[m][k] = *(const PG8_LAS bf16x8*)(lds + PG8_SA(b, h) + aoff + m * 2048 + k * 1024); } while (0)
#define PG8_LDB(dst, b, h) do { _Pragma("unroll") for (int n = 0; n < 2; ++n) _Pragma("unroll") for (int k = 0; k < 2; ++k) dst[n][k] = *(const PG8_LAS bf16x8*)(lds + PG8_SB(b, h) + boff + n * 2048 + k * 1024); } while (0)
#define PG8_MMA(ai, bj, At, Bt) do { __builtin_amdgcn_s_setprio(1); _Pragma("unroll") for (int m = 0; m < 4; ++m) _Pragma("unroll") for (int n = 0; n < 2; ++n) _Pragma("unroll") for (int k = 0; k < 2; ++k) \
        acc[ai][bj][m][n] = __builtin_amdgcn_mfma_f32_16x16x32_f16(__builtin_bit_cast(f16x8, Bt[n][k]), __builtin_bit_cast(f16x8, At[m][k]), acc[ai][bj][m][n], 0, 0, 0); __builtin_amdgcn_s_setprio(0); } while (0)
#define PG8_WAIT_V(n) asm volatile("s_waitcnt vmcnt(" #n ")" ::: "memory")
#define PG8_WAIT_L(n) asm volatile("s_waitcnt lgkmcnt(" #n ")" ::: "memory")
#define PG8_BAR __builtin_amdgcn_s_barrier()
#define PG8_SCHED __builtin_amdgcn_sched_barrier(0)
    Unit cur, nxt; int ui = 0;
    if (!S.next(0, cur)) return;
    f32x4 acc[2][2][4][2];
#pragma unroll
    for (int a = 0; a < 2; ++a)
#pragma unroll
        for (int b = 0; b < 2; ++b)
#pragma unroll
            for (int m = 0; m < 4; ++m)
#pragma unroll
                for (int n = 0; n < 2; ++n) acc[a][b][m][n] = (f32x4){0.f, 0.f, 0.f, 0.f};
    bf16x8 At[4][2], B0[2][2], B1[2][2];
    const char* cA = (const char*)g.A + (size_t)cur.pm * tstep; const char* cB = (const char*)g.Bt + (size_t)cur.pn * tstep;
    S.a_ready(cur);
    if constexpr (SP2) {
        PG8_STAGE(PG8_SB(0, 0), cB, voffB); PG8_STAGE(PG8_SB(0, 1), cB + hstep, voffB); PG8_STAGE(PG8_SA(0, 0), cA, voffA); PG8_STAGE(PG8_SA(0, 1), cA + hstep, voffA);
        if (wr == 1) PG8_BAR;
        PG8_WAIT_V(2); PG8_BAR;
        PG8_STAGE(PG8_SB(1, 0), cB + kstep, voffB); PG8_STAGE(PG8_SA(1, 0), cA + kstep, voffA); PG8_STAGE(PG8_SB(1, 1), cB + hstep + kstep, voffB);
        PG8_WAIT_V(6); PG8_BAR;
    } else {
        PG8_STAGE(PG8_SB(0, 0), cB, voffB); PG8_STAGE(PG8_SA(0, 0), cA, voffA); PG8_STAGE(PG8_SB(0, 1), cB + hstep, voffB); PG8_STAGE(PG8_SA(0, 1), cA + hstep, voffA);
        if (wr == 1) PG8_BAR;
        PG8_WAIT_V(4); PG8_BAR;
        PG8_STAGE(PG8_SB(1, 0), cB + kstep, voffB); PG8_STAGE(PG8_SA(1, 0), cA + kstep, voffA); PG8_STAGE(PG8_SB(1, 1), cB + hstep + kstep, voffB);
        PG8_WAIT_V(6); PG8_BAR;
    }
    for (;;) {
        const bool has_next = S.next(ui + 1, nxt);
        const char* nA = has_next ? (const char*)g.A + (size_t)nxt.pm * tstep : cA; const char* nB = has_next ? (const char*)g.Bt + (size_t)nxt.pn * tstep : cB;
        for (int t = 0; t < nt; t += 2) {
            const bool last = (t == nt - 2);
            const char* a1 = cA + (size_t)(t + 1) * kstep;
            const char* a2 = last ? nA : cA + (size_t)(t + 2) * kstep; const char* b2 = last ? nB : cB + (size_t)(t + 2) * kstep;
            const char* a3 = a2 + kstep; const char* b3 = b2 + kstep;
            if (last && has_next) S.a_ready(nxt);
            if constexpr (SP2) {
            PG8_LDB(B0, 0, 0); PG8_LDB(B1, 0, 1); PG8_SCHED; PG8_LDA(At, 0, 0); PG8_STAGE(PG8_SA(1, 1), a1 + hstep, voffA);
            PG8_WAIT_V(8); PG8_WAIT_L(0); PG8_BAR; PG8_MMA(0, 0, At, B0); PG8_MMA(0, 1, At, B1); PG8_BAR; PG8_SCHED;
            PG8_LDA(At, 0, 1); PG8_STAGE(PG8_SB(0, 0), b2, voffB); PG8_STAGE(PG8_SB(0, 1), b2 + hstep, voffB); PG8_STAGE(PG8_SA(0, 0), a2, voffA);
            PG8_WAIT_V(8); PG8_WAIT_L(0); PG8_BAR; PG8_MMA(1, 0, At, B0); PG8_MMA(1, 1, At, B1); PG8_BAR; PG8_SCHED;
            PG8_LDB(B0, 1, 0); PG8_LDB(B1, 1, 1); PG8_SCHED; PG8_LDA(At, 1, 0); PG8_STAGE(PG8_SA(0, 1), a2 + hstep, voffA);
            PG8_WAIT_V(8); PG8_WAIT_L(0); PG8_BAR; PG8_MMA(0, 0, At, B0); PG8_MMA(0, 1, At, B1); PG8_BAR; PG8_SCHED;
            PG8_LDA(At, 1, 1); PG8_STAGE(PG8_SB(1, 0), b3, voffB); PG8_STAGE(PG8_SB(1, 1), b3 + hstep, voffB); PG8_STAGE(PG8_SA(1, 0), a3, voffA);
            PG8_WAIT_V(8); PG8_WAIT_L(0); PG8_BAR; PG8_MMA(1, 0, At, B0); PG8_MMA(1, 1, At, B1); PG8_BAR; PG8_SCHED;
            } else {
            PG8_LDB(B0, 0, 0); PG8_SCHED; PG8_LDA(At, 0, 0); PG8_STAGE(PG8_SA(1, 1), a1 + hstep, voffA);
            PG8_WAIT_L(8); PG8_BAR; PG8_WAIT_L(0); PG8_MMA(0, 0, At, B0); PG8_BAR; PG8_SCHED;
            PG8_LDB(B1, 0, 1); PG8_STAGE(PG8_SB(0, 0), b2, voffB);
            PG8_BAR; PG8_WAIT_L(0); PG8_MMA(0, 1, At, B1); PG8_BAR;
            PG8_LDA(At, 0, 1); PG8_STAGE(PG8_SA(0, 0), a2, voffA);
            PG8_BAR; PG8_WAIT_L(0); PG8_MMA(1, 0, At, B0); PG8_BAR; PG8_SCHED;
            PG8_STAGE(PG8_SB(0, 1), b2 + hstep, voffB);
            PG8_WAIT_V(6); PG8_BAR; PG8_MMA(1, 1, At, B1); PG8_BAR;
            PG8_LDB(B0, 1, 0); PG8_SCHED; PG8_LDA(At, 1, 0); PG8_STAGE(PG8_SA(0, 1), a2 + hstep, voffA);
            PG8_WAIT_L(8); PG8_BAR; PG8_WAIT_L(0); PG8_MMA(0, 0, At, B0); PG8_BAR; PG8_SCHED;
            PG8_LDB(B1, 1, 1); PG8_STAGE(PG8_SB(1, 0), b3, voffB);
            PG8_BAR; PG8_WAIT_L(0); PG8_MMA(0, 1, At, B1); PG8_BAR;
            PG8_LDA(At, 1, 1); PG8_STAGE(PG8_SA(1, 0), a3, voffA);
            PG8_BAR; PG8_WAIT_L(0); PG8_MMA(1, 0, At, B0); PG8_BAR; PG8_SCHED;
            PG8_STAGE(PG8_SB(1, 1), b3 + hstep, voffB);
            PG8_WAIT_V(6); PG8_BAR; PG8_MMA(1, 1, At, B1); PG8_BAR;
            }
        }
        if constexpr (ALIGN_EPI) { if (wr == 0) PG8_BAR; }
        if constexpr (!Epi::AFTER_DRAIN) { E(acc, cur, wr, wc, fr, fq); S.done(cur); }
        if (!has_next) break;
#pragma unroll
        for (int a = 0; a < 2; ++a)
#pragma unroll
            for (int b = 0; b < 2; ++b)
#pragma unroll
                for (int m = 0; m < 4; ++m)
#pragma unroll
                    for (int n = 0; n < 2; ++n) acc[a][b][m][n] = (f32x4){0.f, 0.f, 0.f, 0.f};
        cur = nxt; cA = nA; cB = nB; ++ui;
        if constexpr (ALIGN_EPI) { if (wr == 1) PG8_BAR; }
    }
    PG8_WAIT_V(0);
    if constexpr (!ALIGN_EPI) { if (wr == 0) PG8_BAR; }
    PG8_BAR;
    if constexpr (Epi::AFTER_DRAIN) { E.fused(acc, cur, wr, wc, fr, fq, lds, wid, lane); S.done(cur); }
#undef PG8_SA
#undef PG8_SB
#undef PG8_STAGE
#undef PG8_LDA
#undef PG8_LDB
#undef PG8_MMA
#undef PG8_WAIT_V
#undef PG8_WAIT_L
#undef PG8_BAR
#undef PG8_SCHED
}
}

namespace cg = cooperative_groups;
namespace pg8 {
struct EpiF32 {
    static constexpr bool PERM = false, AFTER_DRAIN = false;
    float* O; int ldc; const float* res; float alpha;
    __device__ __forceinline__ void operator()(const f32x4 (&acc)[2][2][4][2], const Unit& u, int wr, int wc, int fr, int fq) const {
        const int row0 = u.pm * BM + wr * 64 + fr, col0 = u.pn * BM + wc * 32 + 4 * fq;
#pragma unroll
        for (int ai = 0; ai < 2; ++ai)
#pragma unroll
            for (int m = 0; m < 4; ++m) { const size_t off = (size_t)(row0 + ai * HALF + m * 16) * ldc + col0;
#pragma unroll
                for (int bj = 0; bj < 2; ++bj)
#pragma unroll
                    for (int n = 0; n < 2; ++n) { f32x4 v = acc[ai][bj][m][n];
                        if (res) { const f32x4 r = *(const f32x4*)(res + off + bj * HALF + n * 16); v = v + r * alpha; }
                        *(f32x4*)(O + off + bj * HALF + n * 16) = v; } }
    }
};
}

constexpr int BATCH = 4, SEQ = 8192, T = BATCH * SEQ, D = 1024, FF = 4096;
constexpr int QRANK = 384, CRANK = 256, RDIM = 64, INW = 704, INWP = 768;
constexpr int H1 = 8, DQK = 192, DV1 = 128, QW1 = H1 * DQK;
constexpr int H2 = 16, KVH2 = 4, HD2 = 64, QKW2 = 1280;
constexpr float LN_EPS = 1e-5f, RMS_EPS = 1e-6f;
constexpr float ALPHA = 1.4142135623730951f;
constexpr float LOG2E = 1.4426950408889634f;
constexpr float QSCALE1 = 0.07216878364870322f * LOG2E;
constexpr float QSCALE2 = 0.125f * LOG2E;

constexpr size_t MiB = 1u << 20;
constexpr size_t WS_CTL = 0, CTL_ZERO_BYTES = 1 * MiB;
constexpr size_t WS_WIN = 2 * MiB;
constexpr size_t WS_WUQ = WS_WIN + (size_t)INWP * D * 2;
constexpr size_t WS_WUK = WS_WUQ + (size_t)QW1 * QRANK * 2;
constexpr size_t WS_WUV = WS_WUK + (size_t)1024 * CRANK * 2;
constexpr size_t WS_WO1 = WS_WUV + (size_t)1024 * CRANK * 2;
constexpr size_t WS_WUP1 = WS_WO1 + (size_t)D * D * 2;
constexpr size_t WS_WDN1 = WS_WUP1 + (size_t)FF * D * 2;
constexpr size_t WS_WQK2 = WS_WDN1 + (size_t)FF * D * 2;
constexpr size_t WS_WV2 = WS_WQK2 + (size_t)QKW2 * D * 2;
constexpr size_t WS_WO2 = WS_WV2 + (size_t)256 * D * 2;
constexpr size_t WS_WUP2 = WS_WO2 + (size_t)D * D * 2;
constexpr size_t WS_WDN2 = WS_WUP2 + (size_t)FF * D * 2;
constexpr size_t WS_WEND = WS_WDN2 + (size_t)FF * D * 2;
static_assert(WS_WEND <= 48 * MiB, "weights region");
constexpr size_t WS_BFA = 48 * MiB;
constexpr size_t WS_F32A = 112 * MiB;
constexpr size_t WS_KN = 112 * MiB, WS_VT = 176 * MiB;
constexpr size_t WS_H = 240 * MiB;
constexpr size_t WS_O = 240 * MiB;
constexpr size_t WS_CQ = 368 * MiB, WS_CKV = 392 * MiB, WS_KR = 408 * MiB, WS_Q = 412 * MiB;
constexpr size_t WS_HB = 240 * MiB;
constexpr size_t WS_QK2 = 240 * MiB, WS_V2T = 320 * MiB, WS_O2 = 336 * MiB;
constexpr size_t WS_END = 508 * MiB;

constexpr int RING_BYTES = 131072;
constexpr int LDS_BYTES = 147456;
constexpr int NWAVES = 8;

#define LAS __attribute__((address_space(3)))
typedef unsigned short bf16;
typedef unsigned v4u __attribute__((ext_vector_type(4)));
typedef unsigned v2u __attribute__((ext_vector_type(2)));
typedef float f32x4 __attribute__((ext_vector_type(4)));
typedef float f32x16 __attribute__((ext_vector_type(16)));
typedef short bf16x8 __attribute__((ext_vector_type(8)));

typedef _Float16 f16x8 __attribute__((ext_vector_type(8)));
typedef _Float16 f16x2 __attribute__((ext_vector_type(2)));
__device__ __forceinline__ unsigned f2bf(float f) { return (unsigned)__builtin_bit_cast(unsigned short, (_Float16)f); }
__device__ __forceinline__ unsigned pk2(float lo, float hi) { const f16x2 h = {(_Float16)lo, (_Float16)hi}; return __builtin_bit_cast(unsigned, h); }
__device__ __forceinline__ float bf2f(unsigned v) { return (float)__builtin_bit_cast(_Float16, (unsigned short)v); }
#define MFMA32(a, b, c) __builtin_amdgcn_mfma_f32_32x32x16_f16(__builtin_bit_cast(f16x8, a), __builtin_bit_cast(f16x8, b), c, 0, 0, 0)
__device__ __forceinline__ int crow(int r, int hi) { return (r & 3) + 8 * (r >> 2) + 4 * hi; }
__device__ __forceinline__ float wave_sum(float v) {
#pragma unroll
    for (int o = 1; o < 64; o <<= 1) v += __shfl_xor(v, o);
    return v;
}
#define LDS_WAIT() asm volatile("s_waitcnt lgkmcnt(0)" ::: "memory")

static __device__ const float ROPE_INV[32] = {
    1.000000000e+00f, 7.498942614e-01f, 5.623413324e-01f, 4.216965139e-01f, 3.162277639e-01f, 2.371373773e-01f, 1.778279394e-01f, 1.333521307e-01f,
    1.000000015e-01f, 7.498941571e-02f, 5.623413250e-02f, 4.216965288e-02f, 3.162277490e-02f, 2.371373773e-02f, 1.778279431e-02f, 1.333521493e-02f,
    9.999999776e-03f, 7.498941850e-03f, 5.623413250e-03f, 4.216964822e-03f, 3.162277630e-03f, 2.371373586e-03f, 1.778279431e-03f, 1.333521446e-03f,
    1.000000047e-03f, 7.498942432e-04f, 5.623413017e-04f, 4.216965172e-04f, 3.162277571e-04f, 2.371373703e-04f, 1.778279402e-04f, 1.333521504e-04f};

__device__ __forceinline__ void rope_cs(int pos, int i, float& c, float& s) {
    const float ang = (float)pos * ROPE_INV[i];
    double r = (double)ang * 0.15915494309189535;
    r -= __builtin_floor(r);
    const float fr = (float)r;
    s = __builtin_amdgcn_sinf(fr); c = __builtin_amdgcn_cosf(fr);
}


#define GAS __attribute__((address_space(1)))
typedef GAS unsigned gu32;
#define RLX_AGENT __ATOMIC_RELAXED, __HIP_MEMORY_SCOPE_AGENT
constexpr int CW_BAR = 4096;
constexpr int LDSCTL_OFF = RING_BYTES, MISC_OFF = LDSCTL_OFF + 320;
#define XB_TMO      128
#define XB_XCNT(j)  (256  + 64 * (j))
#define XB_XSUB(j)  (1280 + 64 * (j))
#define XB_XGEN(j)  (2304 + 64 * (j))
#define XB_TOP      3328
#define XB_TOPGEN   3392
#define XCD_BAR_WORDS 3456
#define XB_SPIN_CAP (1u << 18)

__device__ __forceinline__ unsigned xb_ld(unsigned* p)              { return __hip_atomic_load(p, __ATOMIC_RELAXED, __HIP_MEMORY_SCOPE_AGENT); }
__device__ __forceinline__ unsigned xb_add(unsigned* p, unsigned v) { return __hip_atomic_fetch_add(p, v, __ATOMIC_RELAXED, __HIP_MEMORY_SCOPE_AGENT); }
__device__ __forceinline__ unsigned xb_xcc_id() { return (unsigned)__builtin_amdgcn_s_getreg((3 << 11) | 20) & 0xFu; }
#define XB_SPIN(cond, bar) do { unsigned _sp = 0; while (cond) { __builtin_amdgcn_s_sleep(1); \
    if ((++_sp & 255u) == 0u) { if (xb_ld(&(bar)[XB_TMO])) break; if (_sp > XB_SPIN_CAP) { atomicAdd(&(bar)[XB_TMO], 1u); break; } } } } while (0)

struct XcdBarrier {
    unsigned* bar; unsigned x;
    volatile LAS unsigned* st;
};

__device__ __forceinline__ XcdBarrier xcd_barrier_post(unsigned* bar, volatile LAS unsigned* st) {
    XcdBarrier b; b.bar = bar; b.x = xb_xcc_id(); b.st = st;
    if (threadIdx.x == 0) (void)xb_add(&bar[XB_XCNT(b.x)], 1u);
    return b;
}
__device__ __forceinline__ void xcd_barrier_complete(unsigned* bar, unsigned x, unsigned& nloc, unsigned& nx) {
    const unsigned G = gridDim.x * gridDim.y * gridDim.z;
    unsigned sum, cnt, mine, sp = 0u;
    for (;;) {
        sum = 0u; cnt = 0u; mine = 0u;
#pragma unroll
        for (unsigned j = 0; j < 16; ++j) { const unsigned c = xb_ld(&bar[XB_XCNT(j)]); sum += c; cnt += (c > 0u) ? 1u : 0u; mine = (j == x) ? c : mine; }
        if (sum == G) break;
        __builtin_amdgcn_s_sleep(1);
        if ((++sp & 255u) == 0u) { if (xb_ld(&bar[XB_TMO])) break; if (sp > XB_SPIN_CAP) { atomicAdd(&bar[XB_TMO], 1u); break; } }
    }
    nloc = mine > 0u ? mine : 1u; nx = cnt > 0u ? cnt : 1u;
}

__device__ __forceinline__ void xcd_barrier(const XcdBarrier& b) {
    asm volatile("s_waitcnt vmcnt(0)" ::: "memory");
    __syncthreads();
    if (threadIdx.x == 0) {
        unsigned* bar = b.bar;
        __builtin_amdgcn_s_waitcnt(0);
        unsigned nloc = b.st[0], nx = b.st[1];
        if (nloc == 0u) { xcd_barrier_complete(bar, b.x, nloc, nx); b.st[0] = nloc; b.st[1] = nx; }
        const unsigned old = xb_add(&bar[XB_XSUB(b.x)], 1u);
        const unsigned gen = old / nloc;
        if (old + 1u == (gen + 1u) * nloc) {
            __builtin_amdgcn_fence(__ATOMIC_RELEASE, "agent");
            asm volatile("s_waitcnt vmcnt(0)" ::: "memory");
            const unsigned og = xb_add(&bar[XB_TOP], 1u);
            const unsigned tg = og / nx;
            if (og + 1u == (tg + 1u) * nx) xb_add(&bar[XB_TOPGEN], 1u);
            else XB_SPIN(xb_ld(&bar[XB_TOPGEN]) == tg, bar);
            __builtin_amdgcn_fence(__ATOMIC_ACQUIRE, "agent");
            xb_add(&bar[XB_XGEN(b.x)], 1u);
            asm volatile("s_waitcnt vmcnt(0)" ::: "memory");
        } else {
            XB_SPIN(xb_ld(&bar[XB_XGEN(b.x)]) == gen, bar);
            __builtin_amdgcn_fence(__ATOMIC_ACQUIRE, "agent");
            asm volatile("s_waitcnt vmcnt(0)" ::: "memory");
        }
    }
    __syncthreads();
}
struct Args { const float* in[19]; float* out; unsigned char* ws; };
struct Frame {
    LAS unsigned char* lds;
    int tid, lane, wave, vcu, G;
    unsigned char* ws;
};

__device__ __forceinline__ void tr_item(const float* W, int ldw, int K, int N, bf16* WT, int row_off, float scale, LAS float* scr, int item, int lane) {
    const int nblk = N / 32, kb = item / nblk, nb = item % nblk, k0 = 64 * kb, n0 = 32 * nb;
#pragma unroll 8
    for (int i = 0; i < 32; ++i) { const int kk = 2 * i + (lane >> 5); scr[kk * 33 + (lane & 31)] = W[(size_t)(k0 + kk) * ldw + n0 + (lane & 31)]; }
    LDS_WAIT(); asm volatile("" ::: "memory");
    const int c = lane & 7;
#pragma unroll
    for (int j = 0; j < 4; ++j) { const int n = (lane >> 3) + 8 * j; const LAS float* s = scr + (8 * c) * 33 + n;
        v4u o; o.x = pk2(s[0 * 33] * scale, s[1 * 33] * scale); o.y = pk2(s[2 * 33] * scale, s[3 * 33] * scale); o.z = pk2(s[4 * 33] * scale, s[5 * 33] * scale); o.w = pk2(s[6 * 33] * scale, s[7 * 33] * scale);
        *(v4u*)(WT + (size_t)(row_off + n0 + n) * K + k0 + 8 * c) = o; }
    LDS_WAIT(); asm volatile("" ::: "memory");
}
__device__ __forceinline__ void p0_prologue(Frame& F, const Args& A) {
    LAS float* scr = (LAS float*)(F.lds + F.wave * 16384);
    const int gw = F.vcu * NWAVES + F.wave, NGW = F.G * NWAVES;
    unsigned char* ws = F.ws;
    constexpr int I0 = (D / 64) * (INW / 32), I1 = (QRANK / 64) * (QW1 / 32), I2 = (CRANK / 64) * (1024 / 32), I3 = I2, I4 = (D / 64) * (D / 32),
                  I5 = (D / 64) * (256 / 32), I6 = I5, I7 = I4, I8 = I4, I9 = (D / 64) * (FF / 32), I10 = I9, I11 = (FF / 64) * (D / 32), I12 = I11;
    constexpr int NITEMS = I0 + I1 + I2 + I3 + I4 + I5 + I6 + I7 + I8 + I9 + I10 + I11 + I12;
    for (int it = gw; it < NITEMS; it += NGW) {
        int r = it;
        if (r < I0) { tr_item(A.in[1], INW, D, INW, (bf16*)(ws + WS_WIN), 0, 1.f, scr, r, F.lane); continue; } r -= I0;
        if (r < I1) { tr_item(A.in[4], QW1, QRANK, QW1, (bf16*)(ws + WS_WUQ), 0, QSCALE1, scr, r, F.lane); continue; } r -= I1;
        if (r < I2) { tr_item(A.in[5], 1024, CRANK, 1024, (bf16*)(ws + WS_WUK), 0, 1.f, scr, r, F.lane); continue; } r -= I2;
        if (r < I3) { tr_item(A.in[6], 1024, CRANK, 1024, (bf16*)(ws + WS_WUV), 0, 1.f, scr, r, F.lane); continue; } r -= I3;
        if (r < I4) { tr_item(A.in[7], D, D, D, (bf16*)(ws + WS_WO1), 0, 1.f, scr, r, F.lane); continue; } r -= I4;
        if (r < I5) { tr_item(A.in[8], 512, D, 256, (bf16*)(ws + WS_WQK2), 1024, 1.f, scr, r, F.lane); continue; } r -= I5;
        if (r < I6) { tr_item(A.in[8] + 256, 512, D, 256, (bf16*)(ws + WS_WV2), 0, 1.f, scr, r, F.lane); continue; } r -= I6;
        if (r < I7) { tr_item(A.in[9], D, D, D, (bf16*)(ws + WS_WQK2), 0, QSCALE2, scr, r, F.lane); continue; } r -= I7;
        if (r < I8) { tr_item(A.in[11], D, D, D, (bf16*)(ws + WS_WO2), 0, 1.f, scr, r, F.lane); continue; } r -= I8;
        if (r < I9) { tr_item(A.in[13], FF, D, FF, (bf16*)(ws + WS_WUP1), 0, 1.f, scr, r, F.lane); continue; } r -= I9;
        if (r < I10) { tr_item(A.in[13] + (size_t)D * FF, FF, D, FF, (bf16*)(ws + WS_WUP2), 0, 1.f, scr, r, F.lane); continue; } r -= I10;
        if (r < I11) { tr_item(A.in[14], D, FF, D, (bf16*)(ws + WS_WDN1), 0, 1.f, scr, r, F.lane); continue; } r -= I11;
        tr_item(A.in[14] + (size_t)D * FF, D, FF, D, (bf16*)(ws + WS_WDN2), 0, 1.f, scr, r, F.lane);
    }
    { v4u* z = (v4u*)(ws + WS_WIN + (size_t)INW * D * 2); const int n16 = (INWP - INW) * D * 2 / 16;
      for (int i = F.vcu * 512 + F.tid; i < n16; i += F.G * 512) z[i] = (v4u){0u, 0u, 0u, 0u}; }
    { const f32x4* x4 = (const f32x4*)A.in[0]; v4u* o = (v4u*)(ws + WS_BFA); const int n8 = T * D / 8;
      for (int i = F.vcu * 512 + F.tid; i < n8; i += F.G * 512) { const f32x4 a = x4[2 * i], b = x4[2 * i + 1];
          o[i] = (v4u){pk2(a.x, a.y), pk2(a.z, a.w), pk2(b.x, b.y), pk2(b.z, b.w)}; } }
}

__device__ __forceinline__ void p2_latents(Frame& F, const float* gq, const float* gkv) {
    const int gw = F.vcu * NWAVES + F.wave, NGW = F.G * NWAVES, lane = F.lane;
    const float* H = (const float*)(F.ws + WS_H); bf16* CQ = (bf16*)(F.ws + WS_CQ); bf16* CKV = (bf16*)(F.ws + WS_CKV); bf16* KR = (bf16*)(F.ws + WS_KR);
    for (int m = gw; m < T; m += NGW) {
        const float* h = H + (size_t)m * INWP;
        float q[6], kv[4]; float sq = 0.f, sk = 0.f;
#pragma unroll
        for (int j = 0; j < 6; ++j) { q[j] = h[lane + 64 * j]; sq += q[j] * q[j]; }
#pragma unroll
        for (int j = 0; j < 4; ++j) { kv[j] = h[QRANK + lane + 64 * j]; sk += kv[j] * kv[j]; }
        const float rv = h[QRANK + CRANK + lane];
        const float rq = 1.0f / sqrtf(wave_sum(sq) * (1.f / QRANK) + RMS_EPS), rk = 1.0f / sqrtf(wave_sum(sk) * (1.f / CRANK) + RMS_EPS);
#pragma unroll
        for (int j = 0; j < 6; ++j) CQ[(size_t)m * QRANK + lane + 64 * j] = (bf16)f2bf(q[j] * rq * gq[lane + 64 * j]);
#pragma unroll
        for (int j = 0; j < 4; ++j) CKV[(size_t)m * CRANK + lane + 64 * j] = (bf16)f2bf(kv[j] * rk * gkv[lane + 64 * j]);
        float c, s; rope_cs(m & (SEQ - 1), lane & 31, c, s);
        const float pv = __shfl_xor(rv, 32);
        const float o = (lane < 32) ? (rv * c - pv * s) : (pv * s + rv * c);
        KR[(size_t)m * RDIM + lane] = (bf16)f2bf(o);
    }
}
__device__ __forceinline__ void p3b_qrope(Frame& F) {
    const int gw = F.vcu * NWAVES + F.wave, NGW = F.G * NWAVES, lane = F.lane;
    bf16* Q = (bf16*)(F.ws + WS_Q);
    for (int m = gw; m < T; m += NGW) {
        float c, s; rope_cs(m & (SEQ - 1), lane & 31, c, s);
        bf16* qrow = Q + (size_t)m * QW1 + 128 + lane;
        float v[H1];
#pragma unroll
        for (int h = 0; h < H1; ++h) v[h] = bf2f(qrow[h * DQK]);
#pragma unroll
        for (int h = 0; h < H1; ++h) { const float pv = __shfl_xor(v[h], 32); const float o = (lane < 32) ? (v[h] * c - pv * s) : (pv * s + v[h] * c); qrow[h * DQK] = (bf16)f2bf(o); }
    }
}
__device__ __forceinline__ void ln_rows(Frame& F, const float* in, float* out, bf16* outb, const float* g, const float* b) {
    const int gw = F.vcu * NWAVES + F.wave, NGW = F.G * NWAVES, lane = F.lane;
    f32x4 gv[4], bv[4];
#pragma unroll
    for (int j = 0; j < 4; ++j) { gv[j] = ((const f32x4*)g)[lane + 64 * j]; bv[j] = ((const f32x4*)b)[lane + 64 * j]; }
    for (int m = gw; m < T; m += NGW) {
        const f32x4* xr = (const f32x4*)(in + (size_t)m * D) + lane;
        f32x4 v[4]; float s = 0.f;
#pragma unroll
        for (int j = 0; j < 4; ++j) { v[j] = xr[64 * j]; s += (v[j].x + v[j].y) + (v[j].z + v[j].w); }
        const float mean = wave_sum(s) * (1.f / D); float s2 = 0.f;
#pragma unroll
        for (int j = 0; j < 4; ++j) { v[j] = v[j] - mean; s2 += (v[j].x * v[j].x + v[j].y * v[j].y) + (v[j].z * v[j].z + v[j].w * v[j].w); }
        const float rstd = 1.f / sqrtf(wave_sum(s2) * (1.f / D) + LN_EPS);
        f32x4* orow = (f32x4*)(out + (size_t)m * D) + lane;
#pragma unroll
        for (int j = 0; j < 4; ++j) { const f32x4 o = v[j] * rstd * gv[j] + bv[j]; orow[64 * j] = o;
            if (outb) { v2u w; w.x = pk2(o.x, o.y); w.y = pk2(o.z, o.w); ((v2u*)(outb + (size_t)m * D))[lane + 64 * j] = w; } }
    }
}

namespace mla {
constexpr int KP = 400, VP = 136, KBUF = 64 * KP, VBUF = 128 * VP;
constexpr int OFF_K = 0, OFF_V = 2 * KBUF, OFF_WS = OFF_V + 2 * VBUF, LDS_NEED = OFF_WS + NWAVES * 256;
static_assert(LDS_NEED <= RING_BYTES, "mla lds");
__device__ __forceinline__ bf16x8 pack8(const f32x16& p, int b) {
    v4u w; w.x = pk2(p[b], p[b + 1]); w.y = pk2(p[b + 2], p[b + 3]); w.z = pk2(p[b + 4], p[b + 5]); w.w = pk2(p[b + 6], p[b + 7]);
    return __builtin_bit_cast(bf16x8, w);
}
__device__ __forceinline__ void unit(int b, int h, int qb, const bf16* __restrict__ Q, const bf16* __restrict__ KN, const bf16* __restrict__ KR, const bf16* __restrict__ VT, bf16* __restrict__ O, LAS unsigned char* lds) {
    const int tid = threadIdx.x, lane = tid & 63, r32 = lane & 31, hi = lane >> 5; const int wid = __builtin_amdgcn_readfirstlane(tid >> 6);
    const size_t rowbase = (size_t)b * SEQ; const int q0 = qb * 256;
    bf16x8 qf[12];
    { const bf16* qp = Q + (rowbase + q0 + wid * 32 + r32) * QW1 + h * DQK + hi * 8;
#pragma unroll
      for (int d0 = 0; d0 < 12; ++d0) qf[d0] = *(const bf16x8*)(qp + d0 * 16); }
    f32x16 o[4];
#pragma unroll
    for (int d0 = 0; d0 < 4; ++d0)
#pragma unroll
        for (int r = 0; r < 16; ++r) o[d0][r] = 0.f;
    float mhat = 0.f, l = 0.f;
    LAS float* wsf = (LAS float*)(lds + OFF_WS) + wid * 64;
    const int NT = 4 * qb + 4, my_last = 4 * qb + (wid >> 1);
    int kkey[3], kcc[3]; const bf16* ksrc[3];
#pragma unroll
    for (int i = 0; i < 3; ++i) { const int c = tid + 512 * i; kkey[i] = c / 24; kcc[i] = c % 24;
        ksrc[i] = (kcc[i] < 16) ? (KN + (rowbase + kkey[i]) * 1024 + h * 128 + kcc[i] * 8) : (KR + (rowbase + kkey[i]) * RDIM + (kcc[i] - 16) * 8); }
    const size_t kstep0 = (size_t)64 * 1024, kstep1 = (size_t)64 * RDIM;
    int vd[2], vcc[2]; const bf16* vsrc[2];
#pragma unroll
    for (int i = 0; i < 2; ++i) { const int c = tid + 512 * i; vd[i] = c >> 3; vcc[i] = c & 7; vsrc[i] = VT + (size_t)(h * 128 + vd[i]) * T + rowbase + vcc[i] * 8; }
    v4u kst[3], vst[2];
#define MLA_LOAD(t) do { _Pragma("unroll") for (int i = 0; i < 3; ++i) kst[i] = *(const v4u*)(ksrc[i] + (size_t)(t) * ((kcc[i] < 16) ? kstep0 : kstep1)); \
        _Pragma("unroll") for (int i = 0; i < 2; ++i) vst[i] = *(const v4u*)(vsrc[i] + (size_t)(t) * 64); } while (0)
#define MLA_STORE(buf) do { _Pragma("unroll") for (int i = 0; i < 3; ++i) *(LAS v4u*)(lds + OFF_K + (buf) * KBUF + kkey[i] * KP + kcc[i] * 16) = kst[i]; \
        _Pragma("unroll") for (int i = 0; i < 2; ++i) { LAS unsigned char* p = lds + OFF_V + (buf) * VBUF + vd[i] * VP + vcc[i] * 16; \
            *(LAS v2u*)p = (v2u){vst[i].x, vst[i].y}; *(LAS v2u*)(p + 8) = (v2u){vst[i].z, vst[i].w}; } } while (0)
    MLA_LOAD(0); MLA_STORE(0);
    __syncthreads();
    for (int t = 0; t < NT; ++t) {
        const int buf = t & 1;
        if (t + 1 < NT) MLA_LOAD(t + 1);
        if (t <= my_last) {
            const int nh = (t == my_last && !(wid & 1)) ? 1 : 2;
            for (int hh = 0; hh < nh; ++hh) {
            const LAS unsigned char* kb = lds + OFF_K + buf * KBUF + (32 * hh + r32) * KP + hi * 16;
            f32x16 s0;
#pragma unroll
            for (int r = 0; r < 16; ++r) s0[r] = -mhat;
#pragma unroll
            for (int d0 = 0; d0 < 12; ++d0) {
                const bf16x8 a0 = *(const LAS bf16x8*)(kb + d0 * 32);
                s0 = MFMA32(a0, qf[d0], s0);
            }
            if (t == my_last) {
                const int qrel = wid * 32 + r32, kb0 = 64 * t - q0 + 32 * hh + 4 * hi;
#pragma unroll
                for (int r = 0; r < 16; ++r) { const int kv = kb0 + (r & 3) + 8 * (r >> 2); if (kv > qrel) s0[r] = -INFINITY; }
            }
            float rm = s0[0];
#pragma unroll
            for (int r = 1; r < 16; ++r) rm = fmaxf(rm, s0[r]);
            rm = fmaxf(rm, __shfl_xor(rm, 32));
            const bool first = (t == 0 && hh == 0);
            if (first || __any(rm > 8.0f)) {
                const float dl = first ? rm : fmaxf(rm, 0.f);
                mhat += dl;
#pragma unroll
                for (int r = 0; r < 16; ++r) s0[r] -= dl;
                if (!first) {
                    const float f = __builtin_amdgcn_exp2f(-dl); l *= f;
                    if (hi == 0) wsf[r32] = f;
                    LDS_WAIT();
#pragma unroll
                    for (int r = 0; r < 16; ++r) { const float fr = wsf[crow(r, hi)];
#pragma unroll
                        for (int d0 = 0; d0 < 4; ++d0) o[d0][r] *= fr; }
                    LDS_WAIT();
                }
            }
            float sacc = 0.f;
#pragma unroll
            for (int r = 0; r < 16; ++r) { s0[r] = __builtin_amdgcn_exp2f(s0[r]); sacc += s0[r]; }
            l += sacc;
            bf16x8 pa[2]; pa[0] = pack8(s0, 0); pa[1] = pack8(s0, 8);
            const LAS unsigned char* vb = lds + OFF_V + buf * VBUF + r32 * VP + hi * 8 + hh * 64;
#pragma unroll
            for (int d0 = 0; d0 < 4; ++d0)
#pragma unroll
                for (int ks = 0; ks < 2; ++ks) {
                    const v2u lo = *(const LAS v2u*)(vb + d0 * 32 * VP + ks * 32);
                    const v2u h2 = *(const LAS v2u*)(vb + d0 * 32 * VP + ks * 32 + 16);
                    const v4u w = (v4u){lo.x, lo.y, h2.x, h2.y};
                    o[d0] = MFMA32(pa[ks], __builtin_bit_cast(bf16x8, w), o[d0]);
                }
            }
        }
        if (t + 1 < NT) MLA_STORE(buf ^ 1);
        __syncthreads();
    }
#undef MLA_LOAD
#undef MLA_STORE
    l += __shfl_xor(l, 32);
    if (hi == 0) wsf[r32] = 1.0f / l;
    LDS_WAIT();
    float rl[16];
#pragma unroll
    for (int r = 0; r < 16; ++r) rl[r] = wsf[crow(r, hi)];
    LDS_WAIT();
    bf16* Ow = O + (rowbase + q0 + wid * 32) * 1024 + h * 128 + r32;
#pragma unroll
    for (int r = 0; r < 16; ++r) { const int orow = crow(r, hi);
#pragma unroll
        for (int d0 = 0; d0 < 4; ++d0) Ow[(size_t)orow * 1024 + d0 * 32] = (bf16)f2bf(o[d0][r] * rl[r]); }
}
__device__ __forceinline__ void phase(Frame& F) {
    const bf16* Q = (const bf16*)(F.ws + WS_Q); const bf16* KN = (const bf16*)(F.ws + WS_KN); const bf16* KR = (const bf16*)(F.ws + WS_KR); const bf16* VT = (const bf16*)(F.ws + WS_VT);
    bf16* O = (bf16*)(F.ws + WS_O);
    const bool bal = (F.G == 256);
    const int nu = bal ? 4 : (BATCH * H1 * 32 - F.vcu + F.G - 1) / F.G;
    for (int i = 0; i < nu; ++i) {
        int bh, qb;
        if (bal) { const int s = F.vcu & 7; bh = F.vcu >> 3; qb = (i == 0) ? s : (i == 1) ? 15 - s : (i == 2) ? 16 + s : 31 - s; }
        else { const int u = F.vcu + i * F.G; bh = u >> 5; qb = u & 31; }
        unit(bh / H1, bh % H1, qb, Q, KN, KR, VT, O, F.lds);
    }
}
}

namespace swa {
constexpr int KP = 144, VP = 520;
constexpr int OFF_K = 0, OFF_V = 256 * KP, OFF_BT = OFF_V + 64 * VP, OFF_WS = OFF_BT + 1024, LDS_NEED = OFF_WS + NWAVES * 256;
static_assert(LDS_NEED <= RING_BYTES, "swa lds");
__device__ __forceinline__ int t5_bucket(int n) {
    if (n < 16) return n;
    const int v = 16 + (int)(__log2f((float)n * (1.f / 16.f)) * (16.f / 3.f));
    return v < 31 ? v : 31;
}
__device__ __forceinline__ void unit(int b, int n, int kvh, int p, const bf16* __restrict__ QK, const bf16* __restrict__ VT, bf16* __restrict__ O, const float* __restrict__ rel_bias, const float* __restrict__ sinks, LAS unsigned char* lds) {
    const int tid = threadIdx.x, lane = tid & 63, r32 = lane & 31, hi = lane >> 5; const int wid = __builtin_amdgcn_readfirstlane(tid >> 6);
    const long r0 = (long)b * SEQ + 128 * (n - 1);
#pragma unroll
    for (int i = 0; i < 4; ++i) { const int c = tid + 512 * i, key = c >> 3, cc = c & 7;
        v4u v = (v4u){0u, 0u, 0u, 0u};
        if (n > 0 || key >= 128) v = *(const v4u*)(QK + (size_t)(r0 + key) * QKW2 + 1024 + kvh * 64 + cc * 8);
        *(LAS v4u*)(lds + OFF_K + key * KP + cc * 16) = v; }
#pragma unroll
    for (int i = 0; i < 4; ++i) { const int c = tid + 512 * i, d = c >> 5, cc = c & 31;
        v4u v = (v4u){0u, 0u, 0u, 0u};
        if (n > 0 || cc >= 16) v = *(const v4u*)(VT + (size_t)(kvh * 64 + d) * T + r0 + cc * 8);
        LAS unsigned char* pp = lds + OFF_V + d * VP + cc * 16;
        *(LAS v2u*)pp = (v2u){v.x, v.y}; *(LAS v2u*)(pp + 8) = (v2u){v.z, v.w}; }
    LAS float* bt = (LAS float*)(lds + OFF_BT);
    if (tid < 256) { const int hs = tid >> 7, dist = tid & 127; bt[tid] = rel_bias[t5_bucket(dist) * H2 + kvh * 4 + p * 2 + hs] * LOG2E; }
    __syncthreads();
    const int hs = wid >> 2, wq = wid & 3, head = kvh * 4 + p * 2 + hs;
    const size_t qrow = (size_t)b * SEQ + 128 * n + 32 * wq;
    bf16x8 qf[4];
    { const bf16* qp = QK + (qrow + r32) * QKW2 + head * 64 + hi * 8;
#pragma unroll
      for (int d0 = 0; d0 < 4; ++d0) qf[d0] = *(const bf16x8*)(qp + d0 * 16); }
    f32x16 s[5];
    const float sinkl = sinks[head] * LOG2E;
    float m = sinkl;
    const LAS float* btw = bt + hs * 128;
#pragma unroll
    for (int kb = 0; kb < 5; ++kb) {
        const int jb = wq + kb;
        const LAS unsigned char* kp = lds + OFF_K + (32 * jb + r32) * KP + hi * 16;
#pragma unroll
        for (int r = 0; r < 16; ++r) s[kb][r] = 0.f;
#pragma unroll
        for (int d0 = 0; d0 < 4; ++d0) { const bf16x8 a = *(const LAS bf16x8*)(kp + d0 * 32); s[kb] = MFMA32(a, qf[d0], s[kb]); }
#pragma unroll
        for (int r = 0; r < 16; ++r) { const int j = 32 * jb + crow(r, hi), dist = 32 * wq + r32 + 128 - j;
            const bool valid = (dist >= 0) && (dist < 128) && (n > 0 || j >= 128);
            const float bias = btw[dist & 127];
            s[kb][r] = valid ? (s[kb][r] + bias) : -INFINITY; m = fmaxf(m, s[kb][r]); }
    }
    m = fmaxf(m, __shfl_xor(m, 32));
    float lsum = 0.f;
#pragma unroll
    for (int kb = 0; kb < 5; ++kb)
#pragma unroll
        for (int r = 0; r < 16; ++r) { s[kb][r] = __builtin_amdgcn_exp2f(s[kb][r] - m); lsum += s[kb][r]; }
    lsum += __shfl_xor(lsum, 32);
    const float denom = lsum + __builtin_amdgcn_exp2f(sinkl - m);
    f32x16 o[2];
#pragma unroll
    for (int d0 = 0; d0 < 2; ++d0)
#pragma unroll
        for (int r = 0; r < 16; ++r) o[d0][r] = 0.f;
#pragma unroll
    for (int kb = 0; kb < 5; ++kb) {
        const int jb = wq + kb;
        bf16x8 pa[2]; pa[0] = mla::pack8(s[kb], 0); pa[1] = mla::pack8(s[kb], 8);
#pragma unroll
        for (int d0 = 0; d0 < 2; ++d0)
#pragma unroll
            for (int ks = 0; ks < 2; ++ks) {
                const LAS unsigned char* vb = lds + OFF_V + (32 * d0 + r32) * VP + (32 * jb + 16 * ks + 4 * hi) * 2;
                const v2u lo = *(const LAS v2u*)vb; const v2u h2 = *(const LAS v2u*)(vb + 16);
                const v4u w = (v4u){lo.x, lo.y, h2.x, h2.y};
                o[d0] = MFMA32(pa[ks], __builtin_bit_cast(bf16x8, w), o[d0]);
            }
    }
    LAS float* wsf = (LAS float*)(lds + OFF_WS) + wid * 64;
    if (hi == 0) wsf[r32] = 1.0f / denom;
    LDS_WAIT();
    float rl[16];
#pragma unroll
    for (int r = 0; r < 16; ++r) rl[r] = wsf[crow(r, hi)];
    LDS_WAIT();
    bf16* Ow = O + qrow * 1024 + head * 64 + r32;
#pragma unroll
    for (int r = 0; r < 16; ++r) { const int orow = crow(r, hi);
#pragma unroll
        for (int d0 = 0; d0 < 2; ++d0) Ow[(size_t)orow * 1024 + d0 * 32] = (bf16)f2bf(o[d0][r] * rl[r]); }
    __syncthreads();
}
__device__ __forceinline__ void phase(Frame& F, const float* rel_bias, const float* sinks) {
    const bf16* QK = (const bf16*)(F.ws + WS_QK2); const bf16* VT = (const bf16*)(F.ws + WS_V2T); bf16* O = (bf16*)(F.ws + WS_O2);
    for (int u = F.vcu; u < BATCH * 64 * KVH2 * 2; u += F.G) { const int p = u & 1, kvh = (u >> 1) & 3, n = (u >> 3) & 63, b = u >> 9; unit(b, n, kvh, p, QK, VT, O, rel_bias, sinks, F.lds); }
}
}

__global__ void __launch_bounds__(NWAVES * 64, 2) fwd_megakernel(Args args) {
    extern __shared__ __attribute__((aligned(16))) unsigned char lds_raw[];
    cg::grid_group grid = cg::this_grid();
    Frame F;
    F.lds = (LAS unsigned char*)lds_raw;
    F.tid = threadIdx.x; F.lane = F.tid & 63; F.wave = __builtin_amdgcn_readfirstlane(F.tid >> 6);
    F.G = gridDim.x; { const int bx = blockIdx.x; F.vcu = (F.G % 8 == 0) ? (bx % 8) * (F.G / 8) + bx / 8 : bx; }
    F.ws = args.ws;
    unsigned char* ws = args.ws;
    for (int u = F.tid; u < (LDS_BYTES - LDSCTL_OFF) / 4; u += NWAVES * 64) ((LAS unsigned*)(F.lds + LDSCTL_OFF))[u] = 0u;
    __syncthreads();
    const XcdBarrier bar = xcd_barrier_post((unsigned*)(ws + WS_CTL) + CW_BAR, (volatile LAS unsigned*)(F.lds + MISC_OFF) + 8);
#define GRID_BAR() xcd_barrier(bar)
    bf16* BFA = (bf16*)(ws + WS_BFA); float* F32A = (float*)(ws + WS_F32A); bf16* HB = (bf16*)(ws + WS_HB);
    using pg8::Gemm; using pg8::StaticOrder; using pg8::EpiBf16; using pg8::EpiF32;
#define GEMM_BF16(ACT, Aptr, Bptr, M_, N_, K_, Optr, ldc_, scols, sstride, sc0) do { Gemm g{(const pg8::bf16_t*)(Aptr), (const pg8::bf16_t*)(Bptr), M_, N_, K_}; StaticOrder S; S.init(M_, N_, F.G, (int)blockIdx.x); \
        EpiBf16<ACT> E{(pg8::bf16_t*)(Optr), ldc_, nullptr, scols, sstride, sc0}; pg8::gemm_phase<EpiBf16<ACT>, StaticOrder, true, true>(F.lds, g, S, E); } while (0)
#define GEMM_F32(Aptr, Bptr, M_, N_, K_, Optr, ldc_, resptr, alpha_) do { Gemm g{(const pg8::bf16_t*)(Aptr), (const pg8::bf16_t*)(Bptr), M_, N_, K_}; StaticOrder S; S.init(M_, N_, F.G, (int)blockIdx.x); \
        EpiF32 E{(float*)(Optr), ldc_, resptr, alpha_}; pg8::gemm_phase<EpiF32, StaticOrder, true, true>(F.lds, g, S, E); } while (0)

#ifndef SKIP_P0
    p0_prologue(F, args);
#endif
    grid.sync();
    GEMM_F32(BFA, ws + WS_WIN, T, INWP, D, ws + WS_H, INWP, (const float*)nullptr, 0.f);
    GRID_BAR();
    p2_latents(F, args.in[2], args.in[3]);
    GRID_BAR();
    GEMM_BF16(0, ws + WS_CQ, ws + WS_WUQ, T, QW1, QRANK, ws + WS_Q, QW1, 0, (size_t)0, 1.f);
    GEMM_BF16(0, ws + WS_CKV, ws + WS_WUK, T, 1024, CRANK, ws + WS_KN, 1024, 0, (size_t)0, 1.f);
    GEMM_BF16(0, ws + WS_WUV, ws + WS_CKV, 1024, T, CRANK, ws + WS_VT, T, 0, (size_t)0, 1.f);
    GRID_BAR();
    p3b_qrope(F);
    GRID_BAR();
#ifndef SKIP_MLA
    mla::phase(F);
#endif
    GRID_BAR();
    GEMM_F32(ws + WS_O, ws + WS_WO1, T, D, D, F32A, D, args.in[0], ALPHA);
    GRID_BAR();
    ln_rows(F, F32A, F32A, BFA, args.in[15], args.in[16]);
    GRID_BAR();
    GEMM_BF16(2, BFA, ws + WS_WUP1, T, FF, D, HB, FF, 0, (size_t)0, 1.f);
    GRID_BAR();
    GEMM_F32(HB, ws + WS_WDN1, T, D, FF, F32A, D, (const float*)F32A, ALPHA);
    GRID_BAR();
    ln_rows(F, F32A, F32A, BFA, args.in[17], args.in[18]);
    GRID_BAR();
    GEMM_BF16(0, BFA, ws + WS_WQK2, T, QKW2, D, ws + WS_QK2, QKW2, 0, (size_t)0, 1.f);
    GEMM_BF16(0, ws + WS_WV2, BFA, 256, T, D, ws + WS_V2T, T, 0, (size_t)0, 1.f);
    GRID_BAR();
#ifndef SKIP_SWA
    swa::phase(F, args.in[12], args.in[10]);
#endif
    GRID_BAR();
    GEMM_F32(ws + WS_O2, ws + WS_WO2, T, D, D, F32A, D, (const float*)F32A, ALPHA);
    GRID_BAR();
    ln_rows(F, F32A, F32A, BFA, args.in[15] + D, args.in[16] + D);
    GRID_BAR();
    GEMM_BF16(2, BFA, ws + WS_WUP2, T, FF, D, HB, FF, 0, (size_t)0, 1.f);
    GRID_BAR();
    GEMM_F32(HB, ws + WS_WDN2, T, D, FF, args.out, D, (const float*)F32A, ALPHA);
    GRID_BAR();
    ln_rows(F, args.out, args.out, (bf16*)nullptr, args.in[17] + D, args.in[18] + D);
}

extern "C" void kernel_launch(void* const* d_in, const int* in_sizes, int n_in, void* d_out, int out_size, void* d_ws, size_t ws_size, hipStream_t stream) {
    static int grid = 0;
    if (grid == 0) {
        if (n_in != 19 || in_sizes[0] != T * D || out_size != T * D || ws_size < WS_END) { fprintf(stderr, "kernel_launch: unexpected shapes (n_in %d, in0 %d, out %d, ws %zu)\n", n_in, n_in > 0 ? in_sizes[0] : -1, out_size, ws_size); grid = -1; return; }
        int dev = 0, cus = 0, per_cu = 0;
        if (hipGetDevice(&dev) != hipSuccess || hipDeviceGetAttribute(&cus, hipDeviceAttributeMultiprocessorCount, dev) != hipSuccess) { grid = -1; return; }
        if (hipFuncSetAttribute((const void*)fwd_megakernel, hipFuncAttributeMaxDynamicSharedMemorySize, LDS_BYTES) != hipSuccess) { fprintf(stderr, "kernel_launch: hipFuncSetAttribute failed\n"); grid = -1; return; }
        if (hipOccupancyMaxActiveBlocksPerMultiprocessor(&per_cu, (const void*)fwd_megakernel, NWAVES * 64, LDS_BYTES) != hipSuccess || per_cu < 1) per_cu = 1;
        (void)hipGetLastError();
        grid = cus * per_cu;
    }
    if (grid < 0) return;
    if (hipMemsetAsync((char*)d_ws + WS_CTL, 0, CTL_ZERO_BYTES, stream) != hipSuccess) { fprintf(stderr, "kernel_launch: memset failed\n"); return; }
    Args a{};
    for (int i = 0; i < 19; ++i) a.in[i] = (const float*)d_in[i];
    a.out = (float*)d_out; a.ws = (unsigned char*)d_ws;
    void* kargs[] = {&a};
    hipError_t e = hipLaunchCooperativeKernel((const void*)fwd_megakernel, dim3(grid), dim3(NWAVES * 64), kargs, LDS_BYTES, stream);
    if (e != hipSuccess) fprintf(stderr, "kernel_launch: cooperative launch failed: %s (grid %d)\n", hipGetErrorString(e), grid);
}
```
